# Optimizing an MI355X kernel written in HIP

```python
import jax, jax.numpy as jnp
from jax import lax
import numpy as np

D_MODEL = 2048
BATCH = 8
SEQ = 2048
DEPTH = 1

MLSTM_HEADS = 8
MLSTM_QK_DIM = D_MODEL // 16
MLSTM_V_DIM = D_MODEL // 8
MLSTM_QK_WIDTH = MLSTM_HEADS * MLSTM_QK_DIM
MLSTM_WIDTH = MLSTM_HEADS * MLSTM_V_DIM
CHUNK = 128
CONV_WIDTH = D_MODEL
CONV_K = 3
D_FF = ((8 * D_MODEL // 3 + 255) // 256) * 256
EPS = 1e-6

IN_SIZES = (MLSTM_QK_WIDTH, MLSTM_QK_WIDTH, MLSTM_WIDTH, MLSTM_WIDTH,
            MLSTM_HEADS, MLSTM_HEADS,
            CONV_WIDTH, CONV_WIDTH, CONV_WIDTH,
            D_MODEL, D_MODEL)
IN_WIDTH = sum(IN_SIZES)

kernel_name = "hybrid_mlstm_shortconv_gated_block"


def rmsnorm(x, g):
    xf = x.astype(jnp.float32)
    r = lax.rsqrt(jnp.mean(xf * xf, axis=-1, keepdims=True) + EPS)
    return (xf * r * g.astype(jnp.float32)).astype(x.dtype)


def split_columns(p):
    idx = []
    acc = 0
    for s in IN_SIZES[:-1]:
        acc += s
        idx.append(acc)
    return jnp.split(p, idx, axis=-1)


def mlstm_chunkwise(q, k, v, i_pre, f_pre):
    bsz, s_len, h, dk = q.shape
    dv = v.shape[-1]
    nc = s_len // CHUNK
    f32 = jnp.float32

    def to_chunks(t):
        return t.astype(f32).reshape(bsz, nc, CHUNK, h, -1).transpose(1, 0, 3, 2, 4)

    def gate_chunks(t):
        return t.astype(f32).reshape(bsz, nc, CHUNK, h).transpose(1, 0, 3, 2)

    log_f = jax.nn.log_sigmoid(f_pre.astype(f32))
    xs = (to_chunks(q), to_chunks(k), to_chunks(v), gate_chunks(i_pre), gate_chunks(log_f))
    causal = jnp.tril(jnp.ones((CHUNK, CHUNK), dtype=bool))

    def step(carry, inp):
        c_state, n_state, m_state = carry
        qc, kc, vc, li, lf = inp
        b = jnp.cumsum(lf, axis=-1)
        g = b[..., -1]
        dmat = b[..., :, None] - b[..., None, :] + li[..., None, :]
        dmat = jnp.where(causal, dmat, -jnp.inf)
        m_inter = b + m_state[..., None]
        m_comb = jnp.maximum(m_inter, jnp.max(dmat, axis=-1))
        w = jnp.exp(dmat - m_comb[..., None])
        scores = jnp.einsum('bhtk,bhsk->bhts', qc, kc) * w
        inter = jnp.exp(m_inter - m_comb)
        num = (jnp.einsum('bhts,bhsv->bhtv', scores, vc)
               + inter[..., None] * jnp.einsum('bhtk,bhkv->bhtv', qc, c_state))
        den = jnp.sum(scores, axis=-1) + inter * jnp.einsum('bhtk,bhk->bht', qc, n_state)
        h_out = num / jnp.maximum(jnp.abs(den), jnp.exp(-m_comb))[..., None]
        a = g[..., None] - b + li
        m_new = jnp.maximum(g + m_state, jnp.max(a, axis=-1))
        decay = jnp.exp(g + m_state - m_new)
        wk = jnp.exp(a - m_new[..., None])
        c_new = decay[..., None, None] * c_state + jnp.einsum('bhs,bhsk,bhsv->bhkv', wk, kc, vc)
        n_new = decay[..., None] * n_state + jnp.einsum('bhs,bhsk->bhk', wk, kc)
        return (c_new, n_new, m_new), h_out

    init = (jnp.zeros((bsz, h, dk, dv), f32), jnp.zeros((bsz, h, dk), f32), jnp.zeros((bsz, h), f32))
    _, hs = lax.scan(step, init, xs)
    return hs.transpose(1, 0, 3, 2, 4).reshape(bsz, s_len, h, dv)


def causal_depthwise_conv(u, w):
    s_len = u.shape[1]
    up = jnp.pad(u, ((0, 0), (CONV_K - 1, 0), (0, 0)))
    y = w[0] * up[:, 0:s_len]
    for j in range(1, CONV_K):
        y = y + w[j] * up[:, j:j + s_len]
    return y


def setup_inputs(seed: int = 0) -> dict:
    key = jax.random.key(seed)
    ks = jax.random.split(key, 16)
    f32 = jnp.float32
    nrm = lambda k, shape, scale: (jax.random.normal(k, shape, f32) * scale).astype(f32)
    x = jax.random.normal(ks[0], (BATCH, SEQ, D_MODEL), f32)
    norm_mix = 1.0 + nrm(ks[1], (DEPTH, D_MODEL), 0.02)
    w_in = nrm(ks[2], (DEPTH, D_MODEL, IN_WIDTH), D_MODEL ** -0.5)
    b_igate = nrm(ks[3], (DEPTH, MLSTM_HEADS), 0.1)
    b_fgate = (jnp.linspace(3.0, 6.0, MLSTM_HEADS, dtype=f32)[None, :]
               + nrm(ks[4], (DEPTH, MLSTM_HEADS), 0.1))
    conv_w = nrm(ks[5], (DEPTH, CONV_K, CONV_WIDTH), CONV_K ** -0.5)
    mh_norm = 1.0 + nrm(ks[6], (DEPTH, MLSTM_WIDTH), 0.02)
    w_branch_a = nrm(ks[7], (DEPTH, MLSTM_WIDTH, D_MODEL), MLSTM_WIDTH ** -0.5)
    w_branch_b = nrm(ks[8], (DEPTH, CONV_WIDTH, D_MODEL), CONV_WIDTH ** -0.5)
    w_out = nrm(ks[9], (DEPTH, D_MODEL, D_MODEL), D_MODEL ** -0.5)
    norm_ffn = 1.0 + nrm(ks[10], (DEPTH, D_MODEL), 0.02)
    w_gate = nrm(ks[11], (DEPTH, D_MODEL, D_FF), D_MODEL ** -0.5)
    w_up = nrm(ks[12], (DEPTH, D_MODEL, D_FF), D_MODEL ** -0.5)
    w_down = nrm(ks[13], (DEPTH, D_FF, D_MODEL), D_FF ** -0.5)
    norm_final = 1.0 + nrm(ks[14], (D_MODEL,), 0.02)
    return {"x": x, "norm_mix": norm_mix, "w_in": w_in, "b_igate": b_igate, "b_fgate": b_fgate,
            "conv_w": conv_w, "mh_norm": mh_norm, "w_branch_a": w_branch_a,
            "w_branch_b": w_branch_b, "w_out": w_out, "norm_ffn": norm_ffn,
            "w_gate": w_gate, "w_up": w_up, "w_down": w_down, "norm_final": norm_final}


def reference(x, norm_mix, w_in, b_igate, b_fgate, conv_w, mh_norm, w_branch_a,
              w_branch_b, w_out, norm_ffn, w_gate, w_up, w_down, norm_final):
    bsz, s_len, _ = x.shape
    for l in range(DEPTH):
        h = rmsnorm(x, norm_mix[l])
        proj = jnp.einsum('bsd,de->bse', h, w_in[l])
        q, k, v, o_pre, i_pre, f_pre, cb, cc, cx, ga, gb = split_columns(proj)

        q = q.reshape(bsz, s_len, MLSTM_HEADS, MLSTM_QK_DIM) * (MLSTM_QK_DIM ** -0.5)
        k = k.reshape(bsz, s_len, MLSTM_HEADS, MLSTM_QK_DIM)
        v = v.reshape(bsz, s_len, MLSTM_HEADS, MLSTM_V_DIM)
        hm = mlstm_chunkwise(q, k, v, i_pre + b_igate[l], f_pre + b_fgate[l])
        hm = hm * lax.rsqrt(jnp.mean(hm * hm, axis=-1, keepdims=True) + EPS)
        hm = hm.reshape(bsz, s_len, MLSTM_WIDTH) * mh_norm[l].astype(jnp.float32)
        hm = (jax.nn.sigmoid(o_pre.astype(jnp.float32)) * hm).astype(x.dtype)
        y_a = jnp.einsum('bse,ed->bsd', hm, w_branch_a[l])

        u = causal_depthwise_conv(cc * cx, conv_w[l])
        y_b = jnp.einsum('bse,ed->bsd', cb * u, w_branch_b[l])

        merged = jax.nn.sigmoid(ga) * y_a + jax.nn.sigmoid(gb) * y_b
        x = x + jnp.einsum('bsd,de->bse', merged, w_out[l])

        hf = rmsnorm(x, norm_ffn[l])
        act = jax.nn.silu(jnp.einsum('bsd,df->bsf', hf, w_gate[l])) * jnp.einsum('bsd,df->bsf', hf, w_up[l])
        x = x + jnp.einsum('bsf,fd->bsd', act, w_down[l])
    return rmsnorm(x, norm_final)
```

```cpp
#include <hip/hip_runtime.h>
#include <hip/hip_cooperative_groups.h>
#include <cstdio>
#include <cstdint>
namespace cg = cooperative_groups;

#ifndef MK_LAUNCHES
#define MK_LAUNCHES 1
#endif

#ifndef MK_STOP
#define MK_STOP 11
#endif
#define LAS __attribute__((address_space(3)))
typedef unsigned short bf16_t;
typedef short bf16x8 __attribute__((ext_vector_type(8)));
typedef short s16x4 __attribute__((ext_vector_type(4)));
typedef float f32x4 __attribute__((ext_vector_type(4)));
typedef unsigned u32x4 __attribute__((ext_vector_type(4)));
typedef unsigned u32x2 __attribute__((ext_vector_type(2)));

constexpr int M_ = 16384, D_ = 2048, FF_ = 5632, SEQ_ = 2048, INW_ = 16400;
constexpr float EPS_ = 1e-6f;
constexpr size_t MiB = (size_t)1 << 20;
constexpr size_t WS_WA1 = 0, WS_WB1 = 24 * MiB, WS_WAB = 64 * MiB, WS_WO = 80 * MiB, WS_WGU = 88 * MiB, WS_WD = 132 * MiB;
constexpr size_t WS_QK = 154 * MiB, WS_V = WS_QK + 64 * MiB, WS_O = WS_V + 64 * MiB, WS_GA = WS_O + 64 * MiB, WS_GB = WS_GA + 64 * MiB;
constexpr size_t WS_GATES = WS_GB + 64 * MiB, WS_SSQH = WS_GATES + 1 * MiB, WS_SSQ2 = WS_SSQH + 2 * MiB, WS_SSQ3 = WS_SSQ2 + 2 * MiB, WS_CTR = WS_SSQ3 + 2 * MiB, WS_END = WS_CTR + 4096;
constexpr size_t WS_CCX = WS_GB, WS_MG = WS_QK, WS_X1B = WS_V, WS_ACT = WS_O;
constexpr int LDS_BYTES = 155648;

__device__ __forceinline__ unsigned cvt_pk_bf16(float lo, float hi) { unsigned r; asm volatile("v_cvt_pk_bf16_f32 %0, %1, %2" : "=v"(r) : "v"(lo), "v"(hi)); return r; }
__device__ __forceinline__ float bf_lo(unsigned w) { return __uint_as_float(w << 16); }
__device__ __forceinline__ float bf_hi(unsigned w) { return __uint_as_float(w & 0xffff0000u); }
__device__ __forceinline__ float sigmoidf_(float x) { return __builtin_amdgcn_rcpf(1.f + __expf(-x)); }
__device__ __forceinline__ float wave_sum(float v) {
#pragma unroll
    for (int o = 1; o < 64; o <<= 1) v += __shfl_xor(v, o);
    return v;
}

namespace pg8 {
constexpr int BM = 256, BK = 64, HALF = 128, HTB = HALF * BK * 2, STAGE_BYTES = 8 * HTB, NXCD = 8, WGM = 8;
__device__ __forceinline__ int lds_byte(int r, int c) { const int st = (r >> 4) * 2 + (c >> 5), rr = r & 15, cc = c & 31, ob = rr * 64 + cc * 2; return st * 1024 + (ob ^ (((ob >> 9) & 1) << 5)); }
__device__ __forceinline__ void stage_rc(int b, int& R, int& C) { const int st = b / 1024, sb = b % 1024, swz = sb ^ (((sb >> 9) & 1) << 5); R = (st >> 1) * 16 + swz / 64; C = (st & 1) * 32 + (swz % 64) / 2; }
__device__ __forceinline__ int perm32(int rho) { const int n = rho >> 4, i = rho & 15; return 8 * (i >> 2) + 4 * n + (i & 3); }

struct Unit { int pm, pn; };
struct Gemm { const bf16_t* A; const bf16_t* A2; const bf16_t* Bt; int pn_split; int K; };

__device__ __forceinline__ void map_tile(int wgid, int nM, int nN, int& pm, int& pn) {
    const int nwg = nM * nN;
    { const int q = nwg / NXCD, r = nwg % NXCD, xcd = wgid % NXCD, off = wgid / NXCD; wgid = (xcd < r ? xcd * (q + 1) : r * (q + 1) + (xcd - r) * q) + off; }
    const int nig = WGM * nN, gid = wgid / nig, fm = gid * WGM, gsz = (nM - fm) < WGM ? (nM - fm) : WGM;
    pm = fm + ((wgid % nig) % gsz); pn = (wgid % nig) / gsz;
}
struct StaticOrder {
    int nM, nN, nwg, G, c;
    __device__ void init(int M, int N, int G_, int c_) { nM = M / BM; nN = N / BM; nwg = nM * nN; G = G_; c = c_; }
    __device__ __forceinline__ bool next(int i, Unit& u) const { const long L = (long)i * G + c; if (L >= nwg) return false; map_tile((int)L, nM, nN, u.pm, u.pn); return true; }
};
struct PairOrder {
    int nM, nN, nwg, G, c;
    __device__ void init(int M, int N, int G_, int c_) { nM = M / BM; nN = N / BM; nwg = nM * nN; G = G_; c = c_; }
    __device__ __forceinline__ bool next(int i, Unit& u) const { const long L = (long)(i >> 1) * G + c; if (L >= nwg) return false; map_tile((int)L, nM, nN, u.pm, u.pn); u.pn += (i & 1) * nN; return true; }
};

typedef f32x4 Acc[2][2][4][2];

template <class Epi, class Sched>
__device__ __forceinline__ void gemm_phase(LAS unsigned char* lds, const Gemm g, const Sched& S, const Epi& E) {
    const int tid = threadIdx.x, wid = __builtin_amdgcn_readfirstlane(tid >> 6), lane = tid & 63, wr = wid >> 2, wc = wid & 3, fr = lane & 15, fq = lane >> 4;
    const int K = g.K, nt = K / BK;
    unsigned voffA[2], voffB[2];
#pragma unroll
    for (int i = 0; i < 2; ++i) { int R, C; stage_rc(tid * 16 + i * 8192, R, C); const int Rb = Epi::PERM ? ((R & ~31) + perm32(R & 31)) : R;
        voffA[i] = (unsigned)(R * K + C) * 2u; voffB[i] = (unsigned)(Rb * K + C) * 2u; }
    const size_t kstep = (size_t)(BK * 2);
    const size_t hstep = (size_t)HALF * K * 2;
    const size_t tstep = 2 * hstep;
    const unsigned ldsw = (unsigned)wid * 1024u;
    const int aoff = lds_byte(wr * 64 + fr, fq * 8), boff = lds_byte(wc * 32 + fr, fq * 8);
#define PG8_SA(b, h) (((b) * 2 + (h)) * HTB)
#define PG8_SB(b, h) ((4 + (b) * 2 + (h)) * HTB)
#define PG8_STAGE(bufoff, gbase, voff) do { _Pragma("unroll") for (int _i = 0; _i < 2; ++_i) \
        __builtin_amdgcn_global_load_lds((const unsigned*)((const char*)(gbase) + (voff)[_i]), (LAS unsigned*)(lds + (bufoff) + ldsw + _i * 8192), 16, 0, 0); } while (0)
#define PG8_LDA(dst, b, h) do { _Pragma("unroll") for (int m = 0; m < 4; ++m) _Pragma("unroll") for (int k = 0; k < 2; ++k) dst[m][k] = *(const LAS bf16x8*)(lds + PG8_SA(b, h) + aoff + m * 2048 + k * 1024); } while (0)
#define PG8_LDB(dst, b, h) do { _Pragma("unroll") for (int n = 0; n < 2; ++n) _Pragma("unroll") for (int k = 0; k < 2; ++k) dst[n][k] = *(const LAS bf16x8*)(lds + PG8_SB(b, h) + boff + n * 2048 + k * 1024); } while (0)
#define PG8_MMA(ai, bj, At, Bt) do { __builtin_amdgcn_s_setprio(1); _Pragma("unroll") for (int m = 0; m < 4; ++m) _Pragma("unroll") for (int n = 0; n < 2; ++n) _Pragma("unroll") for (int k = 0; k < 2; ++k) \
        acc[ai][bj][m][n] = __builtin_amdgcn_mfma_f32_16x16x32_bf16(Bt[n][k], At[m][k], acc[ai][bj][m][n], 0, 0, 0); __builtin_amdgcn_s_setprio(0); } while (0)
#define PG8_WAIT_V(n) asm volatile("s_waitcnt vmcnt(" #n ")" ::: "memory")
#define PG8_WAIT_L(n) asm volatile("s_waitcnt lgkmcnt(" #n ")" ::: "memory")
#define PG8_BAR __builtin_amdgcn_s_barrier()
#define PG8_SCHED __builtin_amdgcn_sched_barrier(0)
#define PG8_ZERO() do { _Pragma("unroll") for (int a = 0; a < 2; ++a) _Pragma("unroll") for (int b = 0; b < 2; ++b) _Pragma("unroll") for (int m = 0; m < 4; ++m) _Pragma("unroll") for (int n = 0; n < 2; ++n) acc[a][b][m][n] = (f32x4){0.f, 0.f, 0.f, 0.f}; } while (0)
    Unit cur, nxt; int ui = 0;
    if (!S.next(0, cur)) return;
    Acc acc;
    PG8_ZERO();
    bf16x8 At[4][2], B0[2][2], B1[2][2];
    const char* cA = (const char*)(cur.pn >= g.pn_split ? g.A2 : g.A) + (size_t)cur.pm * tstep; const char* cB = (const char*)g.Bt + (size_t)cur.pn * tstep;
    PG8_STAGE(PG8_SB(0, 0), cB, voffB); PG8_STAGE(PG8_SB(0, 1), cB + hstep, voffB); PG8_STAGE(PG8_SA(0, 0), cA, voffA); PG8_STAGE(PG8_SA(0, 1), cA + hstep, voffA);
    if (wr == 1) PG8_BAR;
    PG8_WAIT_V(2); PG8_BAR;
    PG8_STAGE(PG8_SB(1, 0), cB + kstep, voffB); PG8_STAGE(PG8_SA(1, 0), cA + kstep, voffA); PG8_STAGE(PG8_SB(1, 1), cB + hstep + kstep, voffB);
    PG8_WAIT_V(6); PG8_BAR;
    for (;;) {
        const bool has_next = S.next(ui + 1, nxt);
        const char* nA = has_next ? (const char*)(nxt.pn >= g.pn_split ? g.A2 : g.A) + (size_t)nxt.pm * tstep : cA; const char* nB = has_next ? (const char*)g.Bt + (size_t)nxt.pn * tstep : cB;
        for (int t = 0; t < nt; t += 2) {
            const bool last = (t == nt - 2);
            const char* a1 = cA + (size_t)(t + 1) * kstep;
            const char* a2 = last ? nA : cA + (size_t)(t + 2) * kstep; const char* b2 = last ? nB : cB + (size_t)(t + 2) * kstep;
            const char* a3 = a2 + kstep; const char* b3 = b2 + kstep;
            PG8_LDB(B0, 0, 0); PG8_LDB(B1, 0, 1); PG8_SCHED; PG8_LDA(At, 0, 0); PG8_STAGE(PG8_SA(1, 1), a1 + hstep, voffA);
            PG8_WAIT_V(8); PG8_WAIT_L(0); PG8_BAR; PG8_MMA(0, 0, At, B0); PG8_MMA(0, 1, At, B1); PG8_BAR; PG8_SCHED;
            PG8_LDA(At, 0, 1); PG8_STAGE(PG8_SB(0, 0), b2, voffB); PG8_STAGE(PG8_SB(0, 1), b2 + hstep, voffB); PG8_STAGE(PG8_SA(0, 0), a2, voffA);
            PG8_WAIT_V(8); PG8_WAIT_L(0); PG8_BAR; PG8_MMA(1, 0, At, B0); PG8_MMA(1, 1, At, B1); PG8_BAR; PG8_SCHED;
            PG8_LDB(B0, 1, 0); PG8_LDB(B1, 1, 1); PG8_SCHED; PG8_LDA(At, 1, 0); PG8_STAGE(PG8_SA(0, 1), a2 + hstep, voffA);
            PG8_WAIT_V(8); PG8_WAIT_L(0); PG8_BAR; PG8_MMA(0, 0, At, B0); PG8_MMA(0, 1, At, B1); PG8_BAR; PG8_SCHED;
            PG8_LDA(At, 1, 1); PG8_STAGE(PG8_SB(1, 0), b3, voffB); PG8_STAGE(PG8_SB(1, 1), b3 + hstep, voffB); PG8_STAGE(PG8_SA(1, 0), a3, voffA);
            PG8_WAIT_V(8); PG8_WAIT_L(0); PG8_BAR; PG8_MMA(1, 0, At, B0); PG8_MMA(1, 1, At, B1); PG8_BAR; PG8_SCHED;
        }
        if (wr == 0) PG8_BAR;
        const bool keep = E(acc, cur, wr, wc, fr, fq);
        if (!has_next) break;
        if (!keep) PG8_ZERO();
        cur = nxt; cA = nA; cB = nB; ++ui;
        if (wr == 1) PG8_BAR;
    }
    PG8_WAIT_V(0);
    PG8_BAR;
#undef PG8_SA
#undef PG8_SB
#undef PG8_STAGE
#undef PG8_LDA
#undef PG8_LDB
#undef PG8_MMA
#undef PG8_WAIT_V
#undef PG8_WAIT_L
#undef PG8_BAR
#undef PG8_SCHED
#undef PG8_ZERO
}

__device__ __forceinline__ u32x4 pack8(const f32x4 v0, const f32x4 v1) { u32x4 w; w.x = cvt_pk_bf16(v0[0], v0[1]); w.y = cvt_pk_bf16(v0[2], v0[3]); w.z = cvt_pk_bf16(v1[0], v1[1]); w.w = cvt_pk_bf16(v1[2], v1[3]); return w; }

struct EpiP1a {
    static constexpr bool PERM = true;
    bf16_t* CB; bf16_t* CCX;
    __device__ __forceinline__ bool operator()(Acc& acc, const Unit& u, int wr, int wc, int fr, int fq) const {
        const int row0 = u.pm * BM + wr * 64 + fr;
        if (u.pn < 8) {
            const int col0 = u.pn * BM + wc * 32 + 8 * fq;
#pragma unroll
            for (int ai = 0; ai < 2; ++ai)
#pragma unroll
                for (int m = 0; m < 4; ++m) { bf16_t* rowp = CB + (size_t)(row0 + ai * HALF + m * 16) * D_ + col0;
#pragma unroll
                    for (int bj = 0; bj < 2; ++bj) *(u32x4*)(rowp + bj * HALF) = pack8(acc[ai][bj][m][0], acc[ai][bj][m][1]); }
        } else {
            const int col0 = (u.pn - 8) * HALF + wc * 32 + 8 * fq;
#pragma unroll
            for (int ai = 0; ai < 2; ++ai)
#pragma unroll
                for (int m = 0; m < 4; ++m) { bf16_t* rowp = CCX + (size_t)(row0 + ai * HALF + m * 16) * D_ + col0;
                    *(u32x4*)rowp = pack8(acc[ai][0][m][0] * acc[ai][1][m][0], acc[ai][0][m][1] * acc[ai][1][m][1]); }
        }
        return false;
    }
};
struct EpiP1b {
    static constexpr bool PERM = true;
    bf16_t* O;
    __device__ __forceinline__ bool operator()(Acc& acc, const Unit& u, int wr, int wc, int fr, int fq) const {
        const int row0 = u.pm * BM + wr * 64 + fr; const int t = u.pn >> 3; const bool sg = t >= 2;
        bf16_t* base = O + (size_t)t * M_ * D_; const int col0 = (u.pn & 7) * BM + wc * 32 + 8 * fq;
#pragma unroll
        for (int ai = 0; ai < 2; ++ai)
#pragma unroll
            for (int m = 0; m < 4; ++m) { bf16_t* rowp = base + (size_t)(row0 + ai * HALF + m * 16) * D_ + col0;
#pragma unroll
                for (int bj = 0; bj < 2; ++bj) { f32x4 v0 = acc[ai][bj][m][0], v1 = acc[ai][bj][m][1];
                    if (sg) {
#pragma unroll
                        for (int j = 0; j < 4; ++j) { v0[j] = sigmoidf_(v0[j]); v1[j] = sigmoidf_(v1[j]); } }
                    *(u32x4*)(rowp + bj * HALF) = pack8(v0, v1); } }
        return false;
    }
};
struct EpiP3 {
    static constexpr bool PERM = true;
    const bf16_t* GA; const bf16_t* GB; bf16_t* MG;
    __device__ __forceinline__ bool operator()(Acc& acc, const Unit& u, int wr, int wc, int fr, int fq) const {
        const int row0 = u.pm * BM + wr * 64 + fr; const bool second = u.pn >= 8; const int col0 = (u.pn & 7) * BM + wc * 32 + 8 * fq;
#pragma unroll
        for (int ai = 0; ai < 2; ++ai)
#pragma unroll
            for (int m = 0; m < 4; ++m) { const size_t ro = (size_t)(row0 + ai * HALF + m * 16) * D_ + col0;
#pragma unroll
                for (int bj = 0; bj < 2; ++bj) {
                    const u32x4 gb = *(const u32x4*)(GB + ro + bj * HALF);
                    f32x4 b0 = (f32x4){bf_lo(gb.x), bf_hi(gb.x), bf_lo(gb.y), bf_hi(gb.y)}, b1 = (f32x4){bf_lo(gb.z), bf_hi(gb.z), bf_lo(gb.w), bf_hi(gb.w)};
                    if (!second) {
                        const u32x4 ga = *(const u32x4*)(GA + ro + bj * HALF);
                        const f32x4 a0 = (f32x4){bf_lo(ga.x), bf_hi(ga.x), bf_lo(ga.y), bf_hi(ga.y)}, a1 = (f32x4){bf_lo(ga.z), bf_hi(ga.z), bf_lo(ga.w), bf_hi(ga.w)};
#pragma unroll
                        for (int j = 0; j < 4; ++j) { acc[ai][bj][m][0][j] *= a0[j] * __builtin_amdgcn_rcpf(b0[j]); acc[ai][bj][m][1][j] *= a1[j] * __builtin_amdgcn_rcpf(b1[j]); }
                    } else {
                        *(u32x4*)(MG + ro + bj * HALF) = pack8(acc[ai][bj][m][0] * b0, acc[ai][bj][m][1] * b1);
                    } } }
        return !second;
    }
};
struct EpiP4 {
    static constexpr bool PERM = false;
    const float* X; float* X1; bf16_t* X1B; float* SSQ;
    __device__ __forceinline__ bool operator()(Acc& acc, const Unit& u, int wr, int wc, int fr, int fq) const {
        const int row0 = u.pm * BM + wr * 64 + fr, col0 = u.pn * BM + wc * 32 + 4 * fq;
#pragma unroll
        for (int ai = 0; ai < 2; ++ai)
#pragma unroll
            for (int m = 0; m < 4; ++m) { const int r = row0 + ai * HALF + m * 16; const size_t ro = (size_t)r * D_ + col0; float s = 0.f;
#pragma unroll
                for (int bj = 0; bj < 2; ++bj)
#pragma unroll
                    for (int n = 0; n < 2; ++n) { const f32x4 v = *(const f32x4*)(X + ro + bj * HALF + n * 16) + acc[ai][bj][m][n];
                        *(f32x4*)(X1 + ro + bj * HALF + n * 16) = v; u32x2 w; w.x = cvt_pk_bf16(v[0], v[1]); w.y = cvt_pk_bf16(v[2], v[3]);
                        *(u32x2*)(X1B + ro + bj * HALF + n * 16) = w; s += (v[0] * v[0] + v[1] * v[1]) + (v[2] * v[2] + v[3] * v[3]); }
                s += __shfl_xor(s, 16); s += __shfl_xor(s, 32);
                if (fq == 0) SSQ[(size_t)r * 32 + u.pn * 4 + wc] = s; }
        return false;
    }
};
struct EpiP6 {
    static constexpr bool PERM = false;
    float* XIO; float* SSQ;
    __device__ __forceinline__ bool operator()(Acc& acc, const Unit& u, int wr, int wc, int fr, int fq) const {
        const int row0 = u.pm * BM + wr * 64 + fr, col0 = u.pn * BM + wc * 32 + 4 * fq;
#pragma unroll
        for (int ai = 0; ai < 2; ++ai)
#pragma unroll
            for (int m = 0; m < 4; ++m) { const int r = row0 + ai * HALF + m * 16; const size_t ro = (size_t)r * D_ + col0; float s = 0.f;
#pragma unroll
                for (int bj = 0; bj < 2; ++bj)
#pragma unroll
                    for (int n = 0; n < 2; ++n) { const f32x4 v = *(const f32x4*)(XIO + ro + bj * HALF + n * 16) + acc[ai][bj][m][n];
                        *(f32x4*)(XIO + ro + bj * HALF + n * 16) = v; s += (v[0] * v[0] + v[1] * v[1]) + (v[2] * v[2] + v[3] * v[3]); }
                s += __shfl_xor(s, 16); s += __shfl_xor(s, 32);
                if (fq == 0) SSQ[(size_t)r * 32 + u.pn * 4 + wc] = s; }
        return false;
    }
};
struct EpiP5 {
    static constexpr bool PERM = true;
    const float* SSQ; bf16_t* ACT;
    __device__ __forceinline__ bool operator()(Acc& acc, const Unit& u, int wr, int wc, int fr, int fq) const {
        const int row0 = u.pm * BM + wr * 64 + fr, col0 = u.pn * HALF + wc * 32 + 8 * fq;
#pragma unroll
        for (int ai = 0; ai < 2; ++ai)
#pragma unroll
            for (int m = 0; m < 4; ++m) { const int r = row0 + ai * HALF + m * 16;
                const f32x4 p0 = *(const f32x4*)(SSQ + (size_t)r * 32 + fq * 8), p1 = *(const f32x4*)(SSQ + (size_t)r * 32 + fq * 8 + 4);
                float s = ((p0[0] + p0[1]) + (p0[2] + p0[3])) + ((p1[0] + p1[1]) + (p1[2] + p1[3]));
                s += __shfl_xor(s, 16); s += __shfl_xor(s, 32);
                const float rs = __builtin_amdgcn_rsqf(s * (1.f / D_) + EPS_);
                f32x4 o0, o1;
#pragma unroll
                for (int j = 0; j < 4; ++j) { const float g0 = acc[ai][0][m][0][j] * rs, g1 = acc[ai][0][m][1][j] * rs;
                    o0[j] = g0 * sigmoidf_(g0) * (acc[ai][1][m][0][j] * rs); o1[j] = g1 * sigmoidf_(g1) * (acc[ai][1][m][1][j] * rs); }
                *(u32x4*)(ACT + (size_t)r * FF_ + col0) = pack8(o0, o1); }
        return false;
    }
};
}

__device__ __forceinline__ int item_of(int c) { return (c & 7) * 32 + ((c >> 3) & 31) + (c & ~255); }
__device__ __forceinline__ int row_of(int rr) { const int c = rr >> 3 & 255, w = rr & 7, k = rr >> 11; return item_of(c) * 64 + w * 8 + k; }
__device__ __forceinline__ void tr_item(const float* W, int ldn, int col0, int k0, const float* ksc, float scal, bf16_t* WT, int K, int row0, LAS float* scr, int lane) {
#pragma unroll 8
    for (int i = 0; i < 32; ++i) { const int kk = 2 * i + (lane >> 5); const float s = ksc ? ksc[k0 + kk] * scal : scal;
        scr[kk * 33 + (lane & 31)] = W[(size_t)(k0 + kk) * ldn + col0 + (lane & 31)] * s; }
    const int c = lane & 7;
#pragma unroll
    for (int j = 0; j < 4; ++j) { const int n = (lane >> 3) + 8 * j; const LAS float* s = scr + (8 * c) * 33 + n;
        u32x4 o; o.x = cvt_pk_bf16(s[0 * 33], s[1 * 33]); o.y = cvt_pk_bf16(s[2 * 33], s[3 * 33]); o.z = cvt_pk_bf16(s[4 * 33], s[5 * 33]); o.w = cvt_pk_bf16(s[6 * 33], s[7 * 33]);
        *(u32x4*)(WT + (size_t)(row0 + n) * K + k0 + 8 * c) = o; }
}

struct Params {
    const float* x; const float* norm_mix; const float* w_in; const float* b_i; const float* b_f; const float* conv_w; const float* mh_norm;
    const float* w_a; const float* w_b; const float* w_out; const float* norm_ffn; const float* w_gate; const float* w_up; const float* w_down; const float* norm_final;
    float* out; unsigned char* ws; int ph_lo, ph_hi;
};

__device__ __forceinline__ void p0_weights(const Params& P, LAS unsigned char* lds, int wave, int lane, int gw, int NGW) {
    LAS float* scr = (LAS float*)(lds + wave * 8448);
    constexpr int N_A = 264 * 128, N_ALL = N_A + 16 * 352;
    for (int it = gw; it < N_ALL; it += NGW) {
        int seg, r, K;
        if (it < N_A) { seg = it >> 7; r = it & 127; K = D_; } else { const int q = it - N_A; seg = 264 + q / 352; r = q % 352; K = FF_; }
        const int kb = r >> 2, nb = r & 3;
        const float* W; int ldn, col; const float* ksc = nullptr; float scal = 1.f; bf16_t* WT; int row;
        if (seg < 48) {
            const int p = seg >> 1, hf = seg & 1; W = P.w_in; ldn = INW_; ksc = P.norm_mix; WT = (bf16_t*)(P.ws + WS_WA1); row = seg * 128;
            col = p < 8 ? 6160 + p * 256 + hf * 128 : (hf ? 10256 : 8208) + (p - 8) * 128;
        } else if (seg < 128) {
            const int d = (seg - 48) * 128; W = P.w_in; ldn = INW_; ksc = P.norm_mix; WT = (bf16_t*)(P.ws + WS_WB1); row = d;
            if (d < 1024) scal = 0.08838834764831845f;
            col = d < 6144 ? d : (d < 8192 ? 12304 + (d - 6144) : 14352 + (d - 8192));
        } else if (seg < 160) {
            const int s = seg - 128; W = s < 16 ? P.w_a : P.w_b; ldn = D_; WT = (bf16_t*)(P.ws + WS_WAB); row = s * 128; col = (s & 15) * 128;
        } else if (seg < 176) {
            const int s = seg - 160; W = P.w_out; ldn = D_; WT = (bf16_t*)(P.ws + WS_WO); row = s * 128; col = s * 128;
        } else if (seg < 264) {
            const int s = seg - 176, p = s >> 1, hf = s & 1; W = hf ? P.w_up : P.w_gate; ldn = FF_; ksc = P.norm_ffn; WT = (bf16_t*)(P.ws + WS_WGU); row = s * 128; col = p * 128;
        } else {
            const int s = seg - 264; W = P.w_down; ldn = D_; WT = (bf16_t*)(P.ws + WS_WD); row = s * 128; col = s * 128;
        }
        tr_item(W, ldn, col + nb * 32, kb * 64, ksc, scal, WT, K, row + nb * 32, scr, lane);
    }
}

__device__ __forceinline__ void p0_rows(const Params& P, LAS unsigned char* lds, int tid, int lane, int gw, int NGW) {
    LAS f32x4* wif = (LAS f32x4*)lds;
    for (int p = tid; p < 8192; p += 512) { const int k = p >> 2, q = p & 3, l = (k & 255) >> 2, i = k & 3, j = k >> 8;
        const f32x4 v = *(const f32x4*)(P.w_in + (size_t)k * INW_ + 6144 + 4 * q) * P.norm_mix[k];
        wif[((j * 4 + i) * 4 + q) * 64 + l] = v; }
    __syncthreads();
    bf16_t* XB = (bf16_t*)P.out; float* GATES = (float*)(P.ws + WS_GATES);
    for (int rr = gw; rr < M_; rr += NGW) {
        const int row = row_of(rr);
        const f32x4* xr = (const f32x4*)(P.x + (size_t)row * D_) + lane;
        f32x4 v[8]; float ss = 0.f;
#pragma unroll
        for (int j = 0; j < 8; ++j) { v[j] = xr[64 * j]; ss += (v[j][0] * v[j][0] + v[j][1] * v[j][1]) + (v[j][2] * v[j][2] + v[j][3] * v[j][3]); }
        const float rs = 1.0f / sqrtf(wave_sum(ss) * (1.f / D_) + EPS_);
        u32x2* o8 = (u32x2*)(XB + (size_t)row * D_) + lane;
        f32x4 a[4] = {(f32x4){0.f, 0.f, 0.f, 0.f}, (f32x4){0.f, 0.f, 0.f, 0.f}, (f32x4){0.f, 0.f, 0.f, 0.f}, (f32x4){0.f, 0.f, 0.f, 0.f}};
#pragma unroll
        for (int j = 0; j < 8; ++j) { v[j] = v[j] * rs; u32x2 w; w.x = cvt_pk_bf16(v[j][0], v[j][1]); w.y = cvt_pk_bf16(v[j][2], v[j][3]); o8[64 * j] = w;
#pragma unroll
            for (int i = 0; i < 4; ++i)
#pragma unroll
                for (int q = 0; q < 4; ++q) a[q] += wif[((j * 4 + i) * 4 + q) * 64 + lane] * v[j][i]; }
#pragma unroll
        for (int q = 0; q < 4; ++q)
#pragma unroll
            for (int e = 0; e < 4; ++e) a[q][e] = wave_sum(a[q][e]);
        if (lane == 0) {
            f32x4 g0, g1, g2, g3;
#pragma unroll
            for (int e = 0; e < 4; ++e) { g0[e] = a[0][e] + P.b_i[e]; g1[e] = a[1][e] + P.b_i[4 + e];
                const float f0 = a[2][e] + P.b_f[e], f1 = a[3][e] + P.b_f[4 + e];
                g2[e] = fminf(f0, 0.f) - log1pf(expf(-fabsf(f0))); g3[e] = fminf(f1, 0.f) - log1pf(expf(-fabsf(f1))); }
            f32x4* go = (f32x4*)(GATES + (size_t)row * 16); go[0] = g0; go[1] = g1; go[2] = g2; go[3] = g3;
        }
    }
}

__device__ __forceinline__ void unpack8(const u32x4 w, float (&f)[8]) { f[0] = bf_lo(w.x); f[1] = bf_hi(w.x); f[2] = bf_lo(w.y); f[3] = bf_hi(w.y); f[4] = bf_lo(w.z); f[5] = bf_hi(w.z); f[6] = bf_lo(w.w); f[7] = bf_hi(w.w); }
__device__ __forceinline__ u32x4 pack8f(const float (&f)[8]) { u32x4 w; w.x = cvt_pk_bf16(f[0], f[1]); w.y = cvt_pk_bf16(f[2], f[3]); w.z = cvt_pk_bf16(f[4], f[5]); w.w = cvt_pk_bf16(f[6], f[7]); return w; }

__device__ __forceinline__ void p2a_conv(const Params& P, int tid, int vc) {
    bf16_t* CB = (bf16_t*)P.out + (size_t)M_ * D_; const bf16_t* CCX = (const bf16_t*)(P.ws + WS_CCX);
    const int cg8 = (tid & 255) * 8, rs = tid >> 8;
    float w0[8], w1[8], w2[8];
#pragma unroll
    for (int e = 0; e < 8; ++e) { w0[e] = P.conv_w[cg8 + e]; w1[e] = P.conv_w[D_ + cg8 + e]; w2[e] = P.conv_w[2 * D_ + cg8 + e]; }
    for (int it_ = vc; it_ < M_ / 64; it_ += gridDim.x) {
        const int it = item_of(it_);
        const int r0 = it * 64 + rs * 32;
        float p2[8], p1[8];
        if ((r0 & (SEQ_ - 1)) == 0) {
#pragma unroll
            for (int e = 0; e < 8; ++e) { p2[e] = 0.f; p1[e] = 0.f; }
        } else { unpack8(*(const u32x4*)(CCX + (size_t)(r0 - 2) * D_ + cg8), p2); unpack8(*(const u32x4*)(CCX + (size_t)(r0 - 1) * D_ + cg8), p1); }
#pragma unroll 4
        for (int i = 0; i < 32; ++i) { const size_t o = (size_t)(r0 + i) * D_ + cg8;
            float c[8], b[8], y[8]; unpack8(*(const u32x4*)(CCX + o), c); unpack8(*(const u32x4*)(CB + o), b);
#pragma unroll
            for (int e = 0; e < 8; ++e) { y[e] = b[e] * (w0[e] * p2[e] + w1[e] * p1[e] + w2[e] * c[e]); p2[e] = p1[e]; p1[e] = c[e]; }
            *(u32x4*)(CB + o) = pack8f(y); }
    }
}
__device__ __forceinline__ void p2c_hnorm(const Params& P, int tid, int vc) {
    bf16_t* H = (bf16_t*)P.out; const bf16_t* O = (const bf16_t*)(P.ws + WS_O); const float* SSQH = (const float*)(P.ws + WS_SSQH);
    const int cg8 = (tid & 255) * 8, rs = tid >> 8, hd = (tid & 255) >> 5;
    float g[8];
#pragma unroll
    for (int e = 0; e < 8; ++e) g[e] = P.mh_norm[cg8 + e];
    for (int it_ = vc; it_ < M_ / 64; it_ += gridDim.x) {
        const int it = item_of(it_);
        const int r0 = it * 64 + rs * 32;
#pragma unroll 4
        for (int i = 0; i < 32; ++i) { const int r = r0 + i; const size_t o = (size_t)r * D_ + cg8;
            const f32x4 q = *(const f32x4*)(SSQH + (size_t)r * 32 + hd * 4);
            const float rn = 1.0f / sqrtf(((q[0] + q[1]) + (q[2] + q[3])) * (1.f / 256.f) + EPS_);
            float h[8], s[8], y[8]; unpack8(*(const u32x4*)(H + o), h); unpack8(*(const u32x4*)(O + o), s);
#pragma unroll
            for (int e = 0; e < 8; ++e) y[e] = s[e] * (h[e] * rn * g[e]);
            *(u32x4*)(H + o) = pack8f(y); }
    }
}
__device__ __forceinline__ void p7_final(const Params& P, int lane, int gw, int NGW) {
    const float* SSQ = (const float*)(P.ws + WS_SSQ3);
    f32x4 g[8];
#pragma unroll
    for (int j = 0; j < 8; ++j) g[j] = ((const f32x4*)P.norm_final)[lane + 64 * j];
    for (int rr = gw; rr < M_; rr += NGW) {
        const int row = row_of(rr);
        f32x4* xr = (f32x4*)(P.out + (size_t)row * D_) + lane;
        const float part = lane < 32 ? SSQ[(size_t)row * 32 + lane] : 0.f;
        const float rs = 1.0f / sqrtf(wave_sum(part) * (1.f / D_) + EPS_);
#pragma unroll
        for (int j = 0; j < 8; ++j) { const f32x4 v = xr[64 * j]; xr[64 * j] = v * rs * g[j]; }
    }
}

__device__ __forceinline__ unsigned off_b(unsigned row, unsigned ch) { return 256u * row + 16u * (ch ^ (((row & 3) << 2) | ((row >> 2) & 3))); }
__device__ __forceinline__ bf16x8 row_frag(const LAS unsigned char* img, unsigned lane, unsigned rb, unsigned s) {
    return *(const LAS bf16x8*)(img + off_b((lane & 15) + 16 * rb, 4 * s + (lane >> 4)));
}
__device__ __forceinline__ bf16x8 tr_frag(LAS unsigned char* img, unsigned lane, unsigned c, unsigned ks) {
    const unsigned g = lane >> 4, q = (lane & 15) >> 2, p = lane & 3, row = 32 * ks + 8 * g + q, ch = 2 * c + (p >> 1);
    const s16x4 lo = __builtin_amdgcn_ds_read_tr16_b64_v4i16((LAS s16x4*)(img + off_b(row, ch) + 8 * (p & 1)));
    const s16x4 hi = __builtin_amdgcn_ds_read_tr16_b64_v4i16((LAS s16x4*)(img + off_b(row + 4, ch) + 8 * (p & 1)));
    return (bf16x8){lo[0], lo[1], lo[2], lo[3], hi[0], hi[1], hi[2], hi[3]};
}
constexpr int ML_Q = 0, ML_K = 32768, ML_V = 65536, ML_P = 98304, ML_CT = 131072, ML_SM = 151552;

__device__ __forceinline__ void p2b_mlstm(const Params& P, LAS unsigned char* lds, int tid, int w, int lane, int vc) {
    const bf16_t* QK = (const bf16_t*)(P.ws + WS_QK); const bf16_t* V = (const bf16_t*)(P.ws + WS_V); const float* GATES = (const float*)(P.ws + WS_GATES);
    bf16_t* H = (bf16_t*)P.out; float* SSQH = (float*)(P.ws + WS_SSQH);
    LAS unsigned char* Qi = lds + ML_Q; LAS unsigned char* Ki = lds + ML_K; LAS unsigned char* Vi = lds + ML_V; LAS unsigned char* Pi = lds + ML_P; LAS unsigned char* Ci = lds + ML_CT;
    LAS float* sm_a = (LAS float*)(lds + ML_SM); LAS float* sm_M = sm_a + 128; LAS float* sm_in = sm_a + 256; LAS float* sm_emc = sm_a + 384; LAS float* sm_wk = sm_a + 512; LAS float* sm_dec = sm_a + 640;
    const int tb = w < 4 ? w : 11 - w;
    const int g4 = lane >> 4, l15 = lane & 15;
    for (int uu = vc; uu < 256; uu += gridDim.x) {
        const int unit = (uu & 7) * 32 + (uu >> 3);
        const int b = unit >> 5, hd = (unit >> 2) & 7, sl = unit & 3;
        const size_t rowbase = (size_t)b * SEQ_;
        __syncthreads();
        if (tid < 256) { const int row = tid >> 1, ch = 8 + (tid & 1); u32x4 z = (u32x4){0u, 0u, 0u, 0u}; if (ch == 8) z.x = 0x3F80u; *(LAS u32x4*)(Vi + off_b(row, ch)) = z; }
        f32x4 C[5];
#pragma unroll
        for (int jb = 0; jb < 5; ++jb) C[jb] = (f32x4){0.f, 0.f, 0.f, 0.f};
        float mst = 0.f;
        u32x4 pq[4], pk[4], pv[2]; float gl[4] = {0.f, 0.f, 0.f, 0.f};
#define ML_LOAD(cc) do { const size_t t0_ = rowbase + (size_t)(cc) * 128; \
        _Pragma("unroll") for (int i = 0; i < 4; ++i) { const int p = tid + 512 * i, row = p >> 4, ch = p & 15; const bf16_t* src = QK + (t0_ + row) * D_ + hd * 128 + ch * 8; pq[i] = *(const u32x4*)src; pk[i] = *(const u32x4*)(src + 1024); } \
        _Pragma("unroll") for (int i = 0; i < 2; ++i) { const int p = tid + 512 * i, row = p >> 3, ch = p & 7; pv[i] = *(const u32x4*)(V + (t0_ + row) * D_ + hd * 256 + sl * 64 + ch * 8); } \
        if (w == 0) { const float* gp = GATES + (t0_ + 2 * lane) * 16 + hd; gl[0] = gp[0]; gl[1] = gp[8]; gl[2] = gp[16]; gl[3] = gp[24]; } } while (0)
        ML_LOAD(0);
        for (int c = 0; c < 16; ++c) {
            const size_t t0 = rowbase + (size_t)c * 128;
#pragma unroll
            for (int i = 0; i < 4; ++i) { const int p = tid + 512 * i, row = p >> 4, ch = p & 15; *(LAS u32x4*)(Qi + off_b(row, ch)) = pq[i]; *(LAS u32x4*)(Ki + off_b(row, ch)) = pk[i]; }
#pragma unroll
            for (int i = 0; i < 2; ++i) { const int p = tid + 512 * i, row = p >> 3, ch = p & 7; *(LAS u32x4*)(Vi + off_b(row, ch)) = pv[i]; }
#pragma unroll
            for (int jb = 0; jb < 5; ++jb) { u32x2 wv; wv.x = cvt_pk_bf16(C[jb][0], C[jb][1]); wv.y = cvt_pk_bf16(C[jb][2], C[jb][3]);
                *(LAS u32x2*)(Ci + off_b(16 * jb + l15, 2 * w + (lane >> 5)) + 8 * (g4 & 1)) = wv; }
            if (w == 0) {
                const float li0 = gl[0], lf0 = gl[1], li1 = gl[2], lf1 = gl[3];
                const float ps = lf0 + lf1; float incl = ps;
#pragma unroll
                for (int o = 1; o < 64; o <<= 1) { const float t = __shfl_up(incl, o); if (lane >= o) incl += t; }
                const float b0 = (incl - ps) + lf0, b1 = incl;
                const float a0 = li0 - b0, a1 = li1 - b1;
                float cm = fmaxf(a0, a1);
#pragma unroll
                for (int o = 1; o < 64; o <<= 1) { const float t = __shfl_up(cm, o); if (lane >= o) cm = fmaxf(cm, t); }
                float cme = __shfl_up(cm, 1); if (lane == 0) cme = -INFINITY;
                const float M0 = fmaxf(mst, fmaxf(cme, a0)), M1 = fmaxf(mst, cm);
                const float gtot = __shfl(incl, 63), Ml = __shfl(M1, 63);
                sm_a[2 * lane] = a0; sm_a[2 * lane + 1] = a1; sm_M[2 * lane] = M0; sm_M[2 * lane + 1] = M1;
                sm_in[2 * lane] = __expf(mst - M0); sm_in[2 * lane + 1] = __expf(mst - M1);
                sm_emc[2 * lane] = __expf(-(b0 + M0)); sm_emc[2 * lane + 1] = __expf(-(b1 + M1));
                sm_wk[2 * lane] = __expf(a0 - Ml); sm_wk[2 * lane + 1] = __expf(a1 - Ml);
                if (lane == 0) sm_dec[0] = __expf(mst - Ml);
                mst = gtot + Ml;
            }
            __syncthreads();
            if (c + 1 < 16) ML_LOAD(c + 1);
            bf16x8 qf[4];
#pragma unroll
            for (int s = 0; s < 4; ++s) qf[s] = row_frag(Qi, lane, tb, s);
            const float Mt = sm_M[16 * tb + l15];
            const int tloc = 16 * tb + l15;
            for (int sb = 0; sb <= tb; ++sb) {
                f32x4 sa = (f32x4){0.f, 0.f, 0.f, 0.f};
#pragma unroll
                for (int s = 0; s < 4; ++s) sa = __builtin_amdgcn_mfma_f32_16x16x32_bf16(row_frag(Ki, lane, sb, s), qf[s], sa, 0, 0, 0);
                const f32x4 a4 = *(const LAS f32x4*)(sm_a + 16 * sb + 4 * g4);
                float pe[4];
#pragma unroll
                for (int i = 0; i < 4; ++i) { const int sidx = 16 * sb + 4 * g4 + i; pe[i] = sidx <= tloc ? sa[i] * __expf(a4[i] - Mt) : 0.f; }
                u32x2 wv; wv.x = cvt_pk_bf16(pe[0], pe[1]); wv.y = cvt_pk_bf16(pe[2], pe[3]);
                *(LAS u32x2*)(Pi + off_b(tloc, 2 * sb + (lane >> 5)) + 8 * (g4 & 1)) = wv;
            }
            if ((tb & 1) == 0) *(LAS u32x2*)(Pi + off_b(tloc, 2 * (tb + 1) + (lane >> 5)) + 8 * (g4 & 1)) = (u32x2){0u, 0u};
            const int nks = (tb + 2) >> 1;
            f32x4 o1[5], o2[5];
#pragma unroll
            for (int jb = 0; jb < 5; ++jb) { o1[jb] = (f32x4){0.f, 0.f, 0.f, 0.f}; o2[jb] = (f32x4){0.f, 0.f, 0.f, 0.f}; }
            const float dec = sm_dec[0];
#pragma unroll
            for (int jb = 0; jb < 5; ++jb) C[jb] = C[jb] * dec;
#pragma unroll
            for (int s = 0; s < 4; ++s)
#pragma unroll
                for (int jb = 0; jb < 5; ++jb) o2[jb] = __builtin_amdgcn_mfma_f32_16x16x32_bf16(qf[s], row_frag(Ci, lane, jb, s), o2[jb], 0, 0, 0);
            for (int ks = 0; ks < 4; ++ks) {
                bf16x8 vf[5];
#pragma unroll
                for (int jb = 0; jb < 5; ++jb) vf[jb] = tr_frag(Vi, lane, jb, ks);
                if (ks < nks) { const bf16x8 pf = row_frag(Pi, lane, tb, ks);
#pragma unroll
                    for (int jb = 0; jb < 5; ++jb) o1[jb] = __builtin_amdgcn_mfma_f32_16x16x32_bf16(pf, vf[jb], o1[jb], 0, 0, 0); }
                const bf16x8 kt = tr_frag(Ki, lane, w, ks);
                const f32x4 w0 = *(const LAS f32x4*)(sm_wk + 32 * ks + 8 * g4), w1 = *(const LAS f32x4*)(sm_wk + 32 * ks + 8 * g4 + 4);
                bf16x8 kf; unsigned kw[4];
#pragma unroll
                for (int e = 0; e < 4; ++e) { const float lo = __uint_as_float(((unsigned)(unsigned short)kt[2 * e]) << 16) * (e < 2 ? w0[2 * e] : w1[2 * e - 4]);
                    const float hi = __uint_as_float(((unsigned)(unsigned short)kt[2 * e + 1]) << 16) * (e < 2 ? w0[2 * e + 1] : w1[2 * e - 3]); kw[e] = cvt_pk_bf16(lo, hi); }
                kf = __builtin_bit_cast(bf16x8, (u32x4){kw[0], kw[1], kw[2], kw[3]});
#pragma unroll
                for (int jb = 0; jb < 5; ++jb) C[jb] = __builtin_amdgcn_mfma_f32_16x16x32_bf16(kf, vf[jb], C[jb], 0, 0, 0);
            }
            const f32x4 in4 = *(const LAS f32x4*)(sm_in + 16 * tb + 4 * g4), em4 = *(const LAS f32x4*)(sm_emc + 16 * tb + 4 * g4);
            float sc[4], ssq[4];
#pragma unroll
            for (int i = 0; i < 4; ++i) { const float den = __shfl(o1[4][i] + in4[i] * o2[4][i], lane & 48); sc[i] = __builtin_amdgcn_rcpf(fmaxf(fabsf(den), em4[i])); ssq[i] = 0.f; }
            LAS unsigned char* tmp = Pi + 4096 * tb;
#pragma unroll
            for (int jb = 0; jb < 4; ++jb)
#pragma unroll
                for (int i = 0; i < 4; ++i) { const float hv = (o1[jb][i] + in4[i] * o2[jb][i]) * sc[i]; ssq[i] += hv * hv;
                    *(LAS unsigned short*)(tmp + (4 * g4 + i) * 128 + (16 * jb + l15) * 2) = (unsigned short)(cvt_pk_bf16(hv, 0.f) & 0xffffu); }
#pragma unroll
            for (int i = 0; i < 4; ++i) { float s = ssq[i]; s += __shfl_xor(s, 1); s += __shfl_xor(s, 2); s += __shfl_xor(s, 4); s += __shfl_xor(s, 8);
                if (l15 == 0) SSQH[(t0 + 16 * tb + 4 * g4 + i) * 32 + hd * 4 + sl] = s; }
#pragma unroll
            for (int i = 0; i < 2; ++i) { const int row = lane >> 2, ch = (lane & 3) * 2 + i;
                *(u32x4*)(H + (t0 + 16 * tb + row) * D_ + hd * 256 + sl * 64 + ch * 8) = *(const LAS u32x4*)(tmp + row * 128 + ch * 16); }
            __syncthreads();
        }
#undef ML_LOAD
    }
}

__global__ void __launch_bounds__(512, 2) mk_fwd(Params P) {
    extern __shared__ __attribute__((aligned(16))) unsigned char lds_raw[];
    LAS unsigned char* lds = (LAS unsigned char*)lds_raw;
    const int tid = threadIdx.x, lane = tid & 63, wave = __builtin_amdgcn_readfirstlane(tid >> 6);
    const int G = gridDim.x;
    unsigned char* ws = P.ws;
    int vc;
    {
        unsigned* ctr = (unsigned*)(ws + WS_CTR); LAS unsigned* sh = (LAS unsigned*)(lds + LDS_BYTES - 16);
        if (tid == 0) { const unsigned x = (unsigned)__builtin_amdgcn_s_getreg((3 << 11) | 20) & 7u;
            const unsigned r = __hip_atomic_fetch_add(ctr + x * 64, 1u, __ATOMIC_RELAXED, __HIP_MEMORY_SCOPE_AGENT); sh[0] = x | (r << 8); }
        __syncthreads();
        const unsigned v = sh[0];
        asm volatile("s_waitcnt vmcnt(0)" ::: "memory"); __syncthreads(); cg::this_grid().sync();
        bool even = (G % 8) == 0;
        for (int x = 0; x < 8; ++x) even = even && (__hip_atomic_load(ctr + x * 64, __ATOMIC_RELAXED, __HIP_MEMORY_SCOPE_AGENT) == (unsigned)(G / 8));
        vc = even ? (int)((v & 7u) + 8u * (v >> 8)) : (int)blockIdx.x;
        vc = __builtin_amdgcn_readfirstlane(vc);
    }
    const int gw = vc * 8 + wave, NGW = G * 8;
#define IN(k) (P.ph_lo <= (k) && (k) < P.ph_hi)
#define GRID_SYNC() do { asm volatile("s_waitcnt vmcnt(0)" ::: "memory"); __syncthreads(); cg::this_grid().sync(); \
        if (tid == 0) { __builtin_amdgcn_fence(__ATOMIC_ACQUIRE, "agent"); asm volatile("s_waitcnt vmcnt(0)" ::: "memory"); } __syncthreads(); } while (0)
#define SEAM(k) do { if (IN(k) && IN((k) + 1)) GRID_SYNC(); } while (0)
    bf16_t* XB = (bf16_t*)P.out; bf16_t* CU = XB + (size_t)M_ * D_;
    if (IN(0)) { p0_weights(P, lds, wave, lane, gw, NGW); __syncthreads(); p0_rows(P, lds, tid, lane, gw, NGW); __syncthreads(); }
    SEAM(0);
    if (IN(1)) { pg8::Gemm g{XB, XB, (const bf16_t*)(ws + WS_WA1), 1 << 30, D_}; pg8::StaticOrder S; S.init(M_, 6144, G, vc);
        pg8::EpiP1a E{CU, (bf16_t*)(ws + WS_CCX)}; pg8::gemm_phase(lds, g, S, E); }
    SEAM(1);
    if (IN(2)) p2a_conv(P, tid, vc);
    SEAM(2);
    if (IN(3)) { pg8::Gemm g{XB, XB, (const bf16_t*)(ws + WS_WB1), 1 << 30, D_}; pg8::StaticOrder S; S.init(M_, 10240, G, vc);
        pg8::EpiP1b E{(bf16_t*)(ws + WS_QK)}; pg8::gemm_phase(lds, g, S, E); }
    SEAM(3);
    if (IN(4)) p2b_mlstm(P, lds, tid, wave, lane, vc);
    SEAM(4);
    if (IN(5)) p2c_hnorm(P, tid, vc);
    SEAM(5);
    if (IN(6)) { pg8::Gemm g{XB, CU, (const bf16_t*)(ws + WS_WAB), 8, D_}; pg8::PairOrder S; S.init(M_, D_, G, vc);
        pg8::EpiP3 E{(const bf16_t*)(ws + WS_GA), (const bf16_t*)(ws + WS_GB), (bf16_t*)(ws + WS_MG)}; pg8::gemm_phase(lds, g, S, E); }
    SEAM(6);
    if (IN(7)) { pg8::Gemm g{(const bf16_t*)(ws + WS_MG), nullptr, (const bf16_t*)(ws + WS_WO), 1 << 30, D_}; pg8::StaticOrder S; S.init(M_, D_, G, vc);
        pg8::EpiP4 E{P.x, P.out, (bf16_t*)(ws + WS_X1B), (float*)(ws + WS_SSQ2)}; pg8::gemm_phase(lds, g, S, E); }
    SEAM(7);
    if (IN(8)) { pg8::Gemm g{(const bf16_t*)(ws + WS_X1B), nullptr, (const bf16_t*)(ws + WS_WGU), 1 << 30, D_}; pg8::StaticOrder S; S.init(M_, 2 * FF_, G, vc);
        pg8::EpiP5 E{(const float*)(ws + WS_SSQ2), (bf16_t*)(ws + WS_ACT)}; pg8::gemm_phase(lds, g, S, E); }
    SEAM(8);
    if (IN(9)) { pg8::Gemm g{(const bf16_t*)(ws + WS_ACT), nullptr, (const bf16_t*)(ws + WS_WD), 1 << 30, FF_}; pg8::StaticOrder S; S.init(M_, D_, G, vc);
        pg8::EpiP6 E{P.out, (float*)(ws + WS_SSQ3)}; pg8::gemm_phase(lds, g, S, E); }
    SEAM(9);
    if (IN(10)) p7_final(P, lane, gw, NGW);
#undef IN
#undef SEAM
}

extern "C" void kernel_launch(void* const* d_in, const int* in_sizes, int n_in, void* d_out, int out_size, void* d_ws, size_t ws_size, hipStream_t stream) {
    static int grid = 0;
    if (grid == 0) {
        if (n_in != 15 || out_size != M_ * D_ || ws_size < WS_END) { fprintf(stderr, "kernel_launch: unexpected shapes (n_in %d out %d ws %zu, need %zu)\n", n_in, out_size, ws_size, (size_t)WS_END); grid = -1; return; }
        int dev = 0, cus = 0, per_cu = 0;
        (void)hipGetDevice(&dev); (void)hipDeviceGetAttribute(&cus, hipDeviceAttributeMultiprocessorCount, dev);
        if (hipFuncSetAttribute((const void*)mk_fwd, hipFuncAttributeMaxDynamicSharedMemorySize, LDS_BYTES) != hipSuccess) { fprintf(stderr, "kernel_launch: hipFuncSetAttribute failed\n"); grid = -1; return; }
        if (hipOccupancyMaxActiveBlocksPerMultiprocessor(&per_cu, (const void*)mk_fwd, 512, LDS_BYTES) != hipSuccess || per_cu < 1) { per_cu = 1; (void)hipGetLastError(); }
        if (cus <= 0) cus = 256;
        grid = cus * per_cu;
        fprintf(stderr, "kernel_launch: grid %d (cus %d x %d)\n", grid, cus, per_cu);
    }
    if (grid < 0) return;
    Params p{};
    p.x = (const float*)d_in[0]; p.norm_mix = (const float*)d_in[1]; p.w_in = (const float*)d_in[2]; p.b_i = (const float*)d_in[3]; p.b_f = (const float*)d_in[4];
    p.conv_w = (const float*)d_in[5]; p.mh_norm = (const float*)d_in[6]; p.w_a = (const float*)d_in[7]; p.w_b = (const float*)d_in[8]; p.w_out = (const float*)d_in[9];
    p.norm_ffn = (const float*)d_in[10]; p.w_gate = (const float*)d_in[11]; p.w_up = (const float*)d_in[12]; p.w_down = (const float*)d_in[13]; p.norm_final = (const float*)d_in[14];
    p.out = (float*)d_out; p.ws = (unsigned char*)d_ws;
    p.ph_lo = 0; p.ph_hi = MK_STOP;
    (void)hipMemsetAsync((unsigned char*)d_ws + WS_CTR, 0, 4096, stream);
    void* args[] = {&p};
    hipError_t e = hipLaunchCooperativeKernel((const void*)mk_fwd, dim3(grid), dim3(512), args, LDS_BYTES, stream);
    if (e != hipSuccess) fprintf(stderr, "kernel_launch: cooperative launch failed: %s (grid %d)\n", hipGetErrorString(e), grid);
}
```

```cpp
#include <hip/hip_runtime.h>
#include <hip/hip_cooperative_groups.h>
#include <cstdio>
#include <cstdint>
namespace cg = cooperative_groups;

#ifndef MK_LAUNCHES
#define MK_LAUNCHES 1
#endif

#ifndef MK_TSEL
#define MK_TSEL -1
#endif
#ifndef MK_TEND
#define MK_TEND 1
#endif
#ifndef MK_STOP
#define MK_STOP 11
#endif
#define LAS __attribute__((address_space(3)))
typedef unsigned short bf16_t;
typedef short bf16x8 __attribute__((ext_vector_type(8)));
typedef short s16x4 __attribute__((ext_vector_type(4)));
typedef float f32x4 __attribute__((ext_vector_type(4)));
typedef unsigned u32x4 __attribute__((ext_vector_type(4)));
typedef unsigned u32x2 __attribute__((ext_vector_type(2)));

constexpr int M_ = 16384, D_ = 2048, FF_ = 5632, SEQ_ = 2048, INW_ = 16400;
constexpr float EPS_ = 1e-6f;
constexpr size_t MiB = (size_t)1 << 20;
constexpr size_t WS_WA1 = 0, WS_WB1 = 24 * MiB, WS_WAB = 64 * MiB, WS_WO = 80 * MiB, WS_WGU = 88 * MiB, WS_WD = 132 * MiB;
constexpr size_t WS_QK = 154 * MiB, WS_V = WS_QK + 64 * MiB, WS_O = WS_V + 64 * MiB, WS_GA = WS_O + 64 * MiB, WS_GB = WS_GA + 64 * MiB;
constexpr size_t WS_GATES = WS_GB + 64 * MiB, WS_SSQH = WS_GATES + 1 * MiB, WS_SSQ2 = WS_SSQH + 2 * MiB, WS_SSQ3 = WS_SSQ2 + 2 * MiB, WS_CTR = WS_SSQ3 + 2 * MiB, WS_END = WS_CTR + 4096;
constexpr size_t WS_CCX = WS_GB, WS_MG = WS_QK, WS_X1B = WS_V, WS_ACT = WS_O;
constexpr int LDS_BYTES = 155648;

__device__ __forceinline__ unsigned cvt_pk_bf16(float lo, float hi) { unsigned r; asm volatile("v_cvt_pk_bf16_f32 %0, %1, %2" : "=v"(r) : "v"(lo), "v"(hi)); return r; }
__device__ __forceinline__ float bf_lo(unsigned w) { return __uint_as_float(w << 16); }
__device__ __forceinline__ float bf_hi(unsigned w) { return __uint_as_float(w & 0xffff0000u); }
__device__ __forceinline__ float sigmoidf_(float x) { return __builtin_amdgcn_rcpf(1.f + __expf(-x)); }
__device__ __forceinline__ float wave_sum(float v) {
#pragma unroll
    for (int o = 1; o < 64; o <<= 1) v += __shfl_xor(v, o);
    return v;
}

namespace pg8 {
constexpr int BM = 256, BK = 64, HALF = 128, HTB = HALF * BK * 2, STAGE_BYTES = 8 * HTB, NXCD = 8, WGM = 8;
__device__ __forceinline__ int lds_byte(int r, int c) { const int st = (r >> 4) * 2 + (c >> 5), rr = r & 15, cc = c & 31, ob = rr * 64 + cc * 2; return st * 1024 + (ob ^ (((ob >> 9) & 1) << 5)); }
__device__ __forceinline__ void stage_rc(int b, int& R, int& C) { const int st = b / 1024, sb = b % 1024, swz = sb ^ (((sb >> 9) & 1) << 5); R = (st >> 1) * 16 + swz / 64; C = (st & 1) * 32 + (swz % 64) / 2; }
__device__ __forceinline__ int perm32(int rho) { const int n = rho >> 4, i = rho & 15; return 8 * (i >> 2) + 4 * n + (i & 3); }

struct Unit { int pm, pn; };
struct Gemm { const bf16_t* A; const bf16_t* A2; const bf16_t* Bt; int pn_split; int K; };

__device__ __forceinline__ void map_tile(int wgid, int nM, int nN, int& pm, int& pn) {
    const int nwg = nM * nN;
    { const int q = nwg / NXCD, r = nwg % NXCD, xcd = wgid % NXCD, off = wgid / NXCD; wgid = (xcd < r ? xcd * (q + 1) : r * (q + 1) + (xcd - r) * q) + off; }
    const int nig = WGM * nN, gid = wgid / nig, fm = gid * WGM, gsz = (nM - fm) < WGM ? (nM - fm) : WGM;
    pm = fm + ((wgid % nig) % gsz); pn = (wgid % nig) / gsz;
}
struct StaticOrder {
    int nM, nN, nwg, G, c;
    __device__ void init(int M, int N, int G_, int c_) { nM = M / BM; nN = N / BM; nwg = nM * nN; G = G_; c = c_; }
    __device__ __forceinline__ bool next(int i, Unit& u) const { const long L = (long)i * G + c; if (L >= nwg) return false; map_tile((int)L, nM, nN, u.pm, u.pn); return true; }
};
struct PairOrder {
    int nM, nN, nwg, G, c;
    __device__ void init(int M, int N, int G_, int c_) { nM = M / BM; nN = N / BM; nwg = nM * nN; G = G_; c = c_; }
    __device__ __forceinline__ bool next(int i, Unit& u) const { const long L = (long)(i >> 1) * G + c; if (L >= nwg) return false; map_tile((int)L, nM, nN, u.pm, u.pn); u.pn += (i & 1) * nN; return true; }
};

typedef f32x4 Acc[2][2][4][2];

template <class Epi, class Sched>
__device__ __forceinline__ void gemm_phase(LAS unsigned char* lds, const Gemm g, const Sched& S, const Epi& E) {
    const int tid = threadIdx.x, wid = __builtin_amdgcn_readfirstlane(tid >> 6), lane = tid & 63, wr = wid >> 2, wc = wid & 3, fr = lane & 15, fq = lane >> 4;
    const int K = g.K, nt = K / BK;
    unsigned voffA[2], voffB[2];
#pragma unroll
    for (int i = 0; i < 2; ++i) { int R, C; stage_rc(tid * 16 + i * 8192, R, C); const int Rb = Epi::PERM ? ((R & ~31) + perm32(R & 31)) : R;
        voffA[i] = (unsigned)(R * K + C) * 2u; voffB[i] = (unsigned)(Rb * K + C) * 2u; }
    const size_t kstep = (size_t)(BK * 2);
    const size_t hstep = (size_t)HALF * K * 2;
    const size_t tstep = 2 * hstep;
    const unsigned ldsw = (unsigned)wid * 1024u;
    const int aoff = lds_byte(wr * 64 + fr, fq * 8), boff = lds_byte(wc * 32 + fr, fq * 8);
#define PG8_SA(b, h) (((b) * 2 + (h)) * HTB)
#define PG8_SB(b, h) ((4 + (b) * 2 + (h)) * HTB)
#define PG8_STAGE(bufoff, gbase, voff) do { _Pragma("unroll") for (int _i = 0; _i < 2; ++_i) \
        __builtin_amdgcn_global_load_lds((const unsigned*)((const char*)(gbase) + (voff)[_i]), (LAS unsigned*)(lds + (bufoff) + ldsw + _i * 8192), 16, 0, 0); } while (0)
#define PG8_LDA(dst, b, h) do { _Pragma("unroll") for (int m = 0; m < 4; ++m) _Pragma("unroll") for (int k = 0; k < 2; ++k) dst[m][k] = *(const LAS bf16x8*)(lds + PG8_SA(b, h) + aoff + m * 2048 + k * 1024); } while (0)
#define PG8_LDB(dst, b, h) do { _Pragma("unroll") for (int n = 0; n < 2; ++n) _Pragma("unroll") for (int k = 0; k < 2; ++k) dst[n][k] = *(const LAS bf16x8*)(lds + PG8_SB(b, h) + boff + n * 2048 + k * 1024); } while (0)
#define PG8_MMA(ai, bj, At, Bt) do { __builtin_amdgcn_s_setprio(1); _Pragma("unroll") for (int m = 0; m < 4; ++m) _Pragma("unroll") for (int n = 0; n < 2; ++n) _Pragma("unroll") for (int k = 0; k < 2; ++k) \
        acc[ai][bj][m][n] = __builtin_amdgcn_mfma_f32_16x16x32_bf16(Bt[n][k], At[m][k], acc[ai][bj][m][n], 0, 0, 0); __builtin_amdgcn_s_setprio(0); } while (0)
#define PG8_WAIT_V(n) asm volatile("s_waitcnt vmcnt(" #n ")" ::: "memory")
#define PG8_WAIT_L(n) asm volatile("s_waitcnt lgkmcnt(" #n ")" ::: "memory")
#define PG8_BAR __builtin_amdgcn_s_barrier()
#define PG8_SCHED __builtin_amdgcn_sched_barrier(0)
#define PG8_ZERO() do { _Pragma("unroll") for (int a = 0; a < 2; ++a) _Pragma("unroll") for (int b = 0; b < 2; ++b) _Pragma("unroll") for (int m = 0; m < 4; ++m) _Pragma("unroll") for (int n = 0; n < 2; ++n) acc[a][b][m][n] = (f32x4){0.f, 0.f, 0.f, 0.f}; } while (0)
    Unit cur, nxt; int ui = 0;
    if (!S.next(0, cur)) return;
    Acc acc;
    PG8_ZERO();
    bf16x8 At[4][2], B0[2][2], B1[2][2];
    const char* cA = (const char*)(cur.pn >= g.pn_split ? g.A2 : g.A) + (size_t)cur.pm * tstep; const char* cB = (const char*)g.Bt + (size_t)cur.pn * tstep;
    PG8_STAGE(PG8_SB(0, 0), cB, voffB); PG8_STAGE(PG8_SB(0, 1), cB + hstep, voffB); PG8_STAGE(PG8_SA(0, 0), cA, voffA); PG8_STAGE(PG8_SA(0, 1), cA + hstep, voffA);
    if (wr == 1) PG8_BAR;
    PG8_WAIT_V(2); PG8_BAR;
    PG8_STAGE(PG8_SB(1, 0), cB + kstep, voffB); PG8_STAGE(PG8_SA(1, 0), cA + kstep, voffA); PG8_STAGE(PG8_SB(1, 1), cB + hstep + kstep, voffB);
    PG8_WAIT_V(6); PG8_BAR;
    for (;;) {
        const bool has_next = S.next(ui + 1, nxt);
        const char* nA = has_next ? (const char*)(nxt.pn >= g.pn_split ? g.A2 : g.A) + (size_t)nxt.pm * tstep : cA; const char* nB = has_next ? (const char*)g.Bt + (size_t)nxt.pn * tstep : cB;
        for (int t = 0; t < nt; t += 2) {
            const bool last = (t == nt - 2);
            const char* a1 = cA + (size_t)(t + 1) * kstep;
            const char* a2 = last ? nA : cA + (size_t)(t + 2) * kstep; const char* b2 = last ? nB : cB + (size_t)(t + 2) * kstep;
            const char* a3 = a2 + kstep; const char* b3 = b2 + kstep;
            PG8_LDB(B0, 0, 0); PG8_LDB(B1, 0, 1); PG8_SCHED; PG8_LDA(At, 0, 0); PG8_STAGE(PG8_SA(1, 1), a1 + hstep, voffA);
            PG8_WAIT_V(8); PG8_WAIT_L(0); PG8_BAR; PG8_MMA(0, 0, At, B0); PG8_MMA(0, 1, At, B1); PG8_BAR; PG8_SCHED;
            PG8_LDA(At, 0, 1); PG8_STAGE(PG8_SB(0, 0), b2, voffB); PG8_STAGE(PG8_SB(0, 1), b2 + hstep, voffB); PG8_STAGE(PG8_SA(0, 0), a2, voffA);
            PG8_WAIT_V(8); PG8_WAIT_L(0); PG8_BAR; PG8_MMA(1, 0, At, B0); PG8_MMA(1, 1, At, B1); PG8_BAR; PG8_SCHED;
            PG8_LDB(B0, 1, 0); PG8_LDB(B1, 1, 1); PG8_SCHED; PG8_LDA(At, 1, 0); PG8_STAGE(PG8_SA(0, 1), a2 + hstep, voffA);
            PG8_WAIT_V(8); PG8_WAIT_L(0); PG8_BAR; PG8_MMA(0, 0, At, B0); PG8_MMA(0, 1, At, B1); PG8_BAR; PG8_SCHED;
            PG8_LDA(At, 1, 1); PG8_STAGE(PG8_SB(1, 0), b3, voffB); PG8_STAGE(PG8_SB(1, 1), b3 + hstep, voffB); PG8_STAGE(PG8_SA(1, 0), a3, voffA);
            PG8_WAIT_V(8); PG8_WAIT_L(0); PG8_BAR; PG8_MMA(1, 0, At, B0); PG8_MMA(1, 1, At, B1); PG8_BAR; PG8_SCHED;
        }
        if (wr == 0) PG8_BAR;
        const bool keep = E(acc, cur, wr, wc, fr, fq);
        if (!has_next) break;
        if (!keep) PG8_ZERO();
        cur = nxt; cA = nA; cB = nB; ++ui;
        if (wr == 1) PG8_BAR;
    }
    PG8_WAIT_V(0);
    PG8_BAR;
#undef PG8_SA
#undef PG8_SB
#undef PG8_STAGE
#undef PG8_LDA
#undef PG8_LDB
#undef PG8_MMA
#undef PG8_WAIT_V
#undef PG8_WAIT_L
#undef PG8_BAR
#undef PG8_SCHED
#undef PG8_ZERO
}

__device__ __forceinline__ u32x4 pack8(const f32x4 v0, const f32x4 v1) { u32x4 w; w.x = cvt_pk_bf16(v0[0], v0[1]); w.y = cvt_pk_bf16(v0[2], v0[3]); w.z = cvt_pk_bf16(v1[0], v1[1]); w.w = cvt_pk_bf16(v1[2], v1[3]); return w; }

struct EpiP1a {
    static constexpr bool PERM = true;
    bf16_t* CB; bf16_t* CCX;
    __device__ __forceinline__ bool operator()(Acc& acc, const Unit& u, int wr, int wc, int fr, int fq) const {
        const int row0 = u.pm * BM + wr * 64 + fr;
        if (u.pn < 8) {
            const int col0 = u.pn * BM + wc * 32 + 8 * fq;
#pragma unroll
            for (int ai = 0; ai < 2; ++ai)
#pragma unroll
                for (int m = 0; m < 4; ++m) { bf16_t* rowp = CB + (size_t)(row0 + ai * HALF + m * 16) * D_ + col0;
#pragma unroll
                    for (int bj = 0; bj < 2; ++bj) *(u32x4*)(rowp + bj * HALF) = pack8(acc[ai][bj][m][0], acc[ai][bj][m][1]); }
        } else {
            const int col0 = (u.pn - 8) * HALF + wc * 32 + 8 * fq;
#pragma unroll
            for (int ai = 0; ai < 2; ++ai)
#pragma unroll
                for (int m = 0; m < 4; ++m) { bf16_t* rowp = CCX + (size_t)(row0 + ai * HALF + m * 16) * D_ + col0;
                    *(u32x4*)rowp = pack8(acc[ai][0][m][0] * acc[ai][1][m][0], acc[ai][0][m][1] * acc[ai][1][m][1]); }
        }
        return false;
    }
};
struct EpiP1b {
    static constexpr bool PERM = true;
    bf16_t* O;
    __device__ __forceinline__ bool operator()(Acc& acc, const Unit& u, int wr, int wc, int fr, int fq) const {
        const int row0 = u.pm * BM + wr * 64 + fr; const int t = u.pn >> 3; const bool sg = t >= 2;
        bf16_t* base = O + (size_t)t * M_ * D_; const int col0 = (u.pn & 7) * BM + wc * 32 + 8 * fq;
#pragma unroll
        for (int ai = 0; ai < 2; ++ai)
#pragma unroll
            for (int m = 0; m < 4; ++m) { bf16_t* rowp = base + (size_t)(row0 + ai * HALF + m * 16) * D_ + col0;
#pragma unroll
                for (int bj = 0; bj < 2; ++bj) { f32x4 v0 = acc[ai][bj][m][0], v1 = acc[ai][bj][m][1];
                    if (sg) {
#pragma unroll
                        for (int j = 0; j < 4; ++j) { v0[j] = sigmoidf_(v0[j]); v1[j] = sigmoidf_(v1[j]); } }
                    *(u32x4*)(rowp + bj * HALF) = pack8(v0, v1); } }
        return false;
    }
};
struct EpiP3 {
    static constexpr bool PERM = true;
    const bf16_t* GA; const bf16_t* GB; bf16_t* MG;
    __device__ __forceinline__ bool operator()(Acc& acc, const Unit& u, int wr, int wc, int fr, int fq) const {
        const int row0 = u.pm * BM + wr * 64 + fr; const bool second = u.pn >= 8; const int col0 = (u.pn & 7) * BM + wc * 32 + 8 * fq;
#pragma unroll
        for (int ai = 0; ai < 2; ++ai) {
            u32x4 gb[4][2], ga[4][2];
#pragma unroll
            for (int m = 0; m < 4; ++m)
#pragma unroll
                for (int bj = 0; bj < 2; ++bj) gb[m][bj] = *(const u32x4*)(GB + (size_t)(row0 + ai * HALF + m * 16) * D_ + col0 + bj * HALF);
            if (!second) {
#pragma unroll
                for (int m = 0; m < 4; ++m)
#pragma unroll
                    for (int bj = 0; bj < 2; ++bj) ga[m][bj] = *(const u32x4*)(GA + (size_t)(row0 + ai * HALF + m * 16) * D_ + col0 + bj * HALF);
#pragma unroll
                for (int m = 0; m < 4; ++m)
#pragma unroll
                    for (int bj = 0; bj < 2; ++bj) { const u32x4 b = gb[m][bj], a = ga[m][bj];
                        const f32x4 b0 = (f32x4){bf_lo(b.x), bf_hi(b.x), bf_lo(b.y), bf_hi(b.y)}, b1 = (f32x4){bf_lo(b.z), bf_hi(b.z), bf_lo(b.w), bf_hi(b.w)};
                        const f32x4 a0 = (f32x4){bf_lo(a.x), bf_hi(a.x), bf_lo(a.y), bf_hi(a.y)}, a1 = (f32x4){bf_lo(a.z), bf_hi(a.z), bf_lo(a.w), bf_hi(a.w)};
#pragma unroll
                        for (int j = 0; j < 4; ++j) { acc[ai][bj][m][0][j] *= a0[j] * __builtin_amdgcn_rcpf(b0[j]); acc[ai][bj][m][1][j] *= a1[j] * __builtin_amdgcn_rcpf(b1[j]); } }
            } else {
#pragma unroll
                for (int m = 0; m < 4; ++m)
#pragma unroll
                    for (int bj = 0; bj < 2; ++bj) { const u32x4 b = gb[m][bj];
                        const f32x4 b0 = (f32x4){bf_lo(b.x), bf_hi(b.x), bf_lo(b.y), bf_hi(b.y)}, b1 = (f32x4){bf_lo(b.z), bf_hi(b.z), bf_lo(b.w), bf_hi(b.w)};
                        *(u32x4*)(MG + (size_t)(row0 + ai * HALF + m * 16) * D_ + col0 + bj * HALF) = pack8(acc[ai][bj][m][0] * b0, acc[ai][bj][m][1] * b1); }
            }
        }
        return !second;
    }
};
struct EpiP4 {
    static constexpr bool PERM = false;
    const float* X; float* X1; bf16_t* X1B; float* SSQ;
    __device__ __forceinline__ bool operator()(Acc& acc, const Unit& u, int wr, int wc, int fr, int fq) const {
        const int row0 = u.pm * BM + wr * 64 + fr, col0 = u.pn * BM + wc * 32 + 4 * fq;
#pragma unroll
        for (int ai = 0; ai < 2; ++ai)
#pragma unroll
            for (int m = 0; m < 4; ++m) { const int r = row0 + ai * HALF + m * 16; const size_t ro = (size_t)r * D_ + col0; float s = 0.f;
#pragma unroll
                for (int bj = 0; bj < 2; ++bj)
#pragma unroll
                    for (int n = 0; n < 2; ++n) { const f32x4 v = *(const f32x4*)(X + ro + bj * HALF + n * 16) + acc[ai][bj][m][n];
                        *(f32x4*)(X1 + ro + bj * HALF + n * 16) = v; u32x2 w; w.x = cvt_pk_bf16(v[0], v[1]); w.y = cvt_pk_bf16(v[2], v[3]);
                        *(u32x2*)(X1B + ro + bj * HALF + n * 16) = w; s += (v[0] * v[0] + v[1] * v[1]) + (v[2] * v[2] + v[3] * v[3]); }
                s += __shfl_xor(s, 16); s += __shfl_xor(s, 32);
                if (fq == 0) SSQ[(size_t)r * 32 + u.pn * 4 + wc] = s; }
        return false;
    }
};
struct EpiP6 {
    static constexpr bool PERM = false;
    float* XIO; float* SSQ;
    __device__ __forceinline__ bool operator()(Acc& acc, const Unit& u, int wr, int wc, int fr, int fq) const {
        const int row0 = u.pm * BM + wr * 64 + fr, col0 = u.pn * BM + wc * 32 + 4 * fq;
#pragma unroll
        for (int ai = 0; ai < 2; ++ai)
#pragma unroll
            for (int m = 0; m < 4; ++m) { const int r = row0 + ai * HALF + m * 16; const size_t ro = (size_t)r * D_ + col0; float s = 0.f;
#pragma unroll
                for (int bj = 0; bj < 2; ++bj)
#pragma unroll
                    for (int n = 0; n < 2; ++n) { const f32x4 v = *(const f32x4*)(XIO + ro + bj * HALF + n * 16) + acc[ai][bj][m][n];
                        *(f32x4*)(XIO + ro + bj * HALF + n * 16) = v; s += (v[0] * v[0] + v[1] * v[1]) + (v[2] * v[2] + v[3] * v[3]); }
                s += __shfl_xor(s, 16); s += __shfl_xor(s, 32);
                if (fq == 0) SSQ[(size_t)r * 32 + u.pn * 4 + wc] = s; }
        return false;
    }
};
struct EpiP5 {
    static constexpr bool PERM = true;
    const float* SSQ; bf16_t* ACT;
    __device__ __forceinline__ bool operator()(Acc& acc, const Unit& u, int wr, int wc, int fr, int fq) const {
        const int row0 = u.pm * BM + wr * 64 + fr, col0 = u.pn * HALF + wc * 32 + 8 * fq;
#pragma unroll
        for (int ai = 0; ai < 2; ++ai)
#pragma unroll
            for (int m = 0; m < 4; ++m) { const int r = row0 + ai * HALF + m * 16;
                const f32x4 p0 = *(const f32x4*)(SSQ + (size_t)r * 32 + fq * 8), p1 = *(const f32x4*)(SSQ + (size_t)r * 32 + fq * 8 + 4);
                float s = ((p0[0] + p0[1]) + (p0[2] + p0[3])) + ((p1[0] + p1[1]) + (p1[2] + p1[3]));
                s += __shfl_xor(s, 16); s += __shfl_xor(s, 32);
                const float rs = __builtin_amdgcn_rsqf(s * (1.f / D_) + EPS_);
                f32x4 o0, o1;
#pragma unroll
                for (int j = 0; j < 4; ++j) { const float g0 = acc[ai][0][m][0][j] * rs, g1 = acc[ai][0][m][1][j] * rs;
                    o0[j] = g0 * sigmoidf_(g0) * (acc[ai][1][m][0][j] * rs); o1[j] = g1 * sigmoidf_(g1) * (acc[ai][1][m][1][j] * rs); }
                *(u32x4*)(ACT + (size_t)r * FF_ + col0) = pack8(o0, o1); }
        return false;
    }
};
}

__device__ __forceinline__ int item_of(int c) { return (c & 7) * 32 + ((c >> 3) & 31) + (c & ~255); }
__device__ __forceinline__ int row_of(int rr) { const int c = rr >> 3 & 255, w = rr & 7, k = rr >> 11; return item_of(c) * 64 + w * 8 + k; }
__device__ __forceinline__ void tr_item(const float* W, int ldn, int col0, int k0, const float* ksc, float scal, bf16_t* WT, int K, int row0, LAS float* scr, int lane) {
    const int n4 = (lane & 15) * 4, kq = lane >> 4;
    f32x4 v[16];
#pragma unroll
    for (int i = 0; i < 16; ++i) v[i] = *(const f32x4*)(W + (size_t)(k0 + 4 * i + kq) * ldn + col0 + n4);
#pragma unroll
    for (int i = 0; i < 16; ++i) { const int kk = 4 * i + kq; const float s = ksc ? ksc[k0 + kk] * scal : scal; LAS float* d = scr + kk * 65 + n4;
        d[0] = v[i][0] * s; d[1] = v[i][1] * s; d[2] = v[i][2] * s; d[3] = v[i][3] * s; }
    const int c = lane & 7;
#pragma unroll
    for (int j = 0; j < 8; ++j) { const int n = (lane >> 3) + 8 * j; const LAS float* sp = scr + (8 * c) * 65 + n;
        u32x4 o; o.x = cvt_pk_bf16(sp[0 * 65], sp[1 * 65]); o.y = cvt_pk_bf16(sp[2 * 65], sp[3 * 65]); o.z = cvt_pk_bf16(sp[4 * 65], sp[5 * 65]); o.w = cvt_pk_bf16(sp[6 * 65], sp[7 * 65]);
        *(u32x4*)(WT + (size_t)(row0 + n) * K + k0 + 8 * c) = o; }
}

struct Params {
    const float* x; const float* norm_mix; const float* w_in; const float* b_i; const float* b_f; const float* conv_w; const float* mh_norm;
    const float* w_a; const float* w_b; const float* w_out; const float* norm_ffn; const float* w_gate; const float* w_up; const float* w_down; const float* norm_final;
    float* out; unsigned char* ws; int ph_lo, ph_hi;
};

__device__ __forceinline__ void p0_weights(const Params& P, LAS unsigned char* lds, int wave, int lane, int gw, int NGW) {
    LAS float* scr = (LAS float*)(lds + wave * 16640);
    constexpr int N_A = 264 * 64, N_ALL = N_A + 16 * 176;
    for (int it = gw; it < N_ALL; it += NGW) {
        int seg, r, K;
        if (it < N_A) { seg = it >> 6; r = it & 63; K = D_; } else { const int q = it - N_A; seg = 264 + q / 176; r = q % 176; K = FF_; }
        const int kb = r >> 1, nb = r & 1;
        const float* W; int ldn, col; const float* ksc = nullptr; float scal = 1.f; bf16_t* WT; int row;
        if (seg < 48) {
            const int p = seg >> 1, hf = seg & 1; W = P.w_in; ldn = INW_; ksc = P.norm_mix; WT = (bf16_t*)(P.ws + WS_WA1); row = seg * 128;
            col = p < 8 ? 6160 + p * 256 + hf * 128 : (hf ? 10256 : 8208) + (p - 8) * 128;
        } else if (seg < 128) {
            const int d = (seg - 48) * 128; W = P.w_in; ldn = INW_; ksc = P.norm_mix; WT = (bf16_t*)(P.ws + WS_WB1); row = d;
            if (d < 1024) scal = 0.08838834764831845f;
            col = d < 6144 ? d : (d < 8192 ? 12304 + (d - 6144) : 14352 + (d - 8192));
        } else if (seg < 160) {
            const int s = seg - 128; W = s < 16 ? P.w_a : P.w_b; ldn = D_; WT = (bf16_t*)(P.ws + WS_WAB); row = s * 128; col = (s & 15) * 128;
        } else if (seg < 176) {
            const int s = seg - 160; W = P.w_out; ldn = D_; WT = (bf16_t*)(P.ws + WS_WO); row = s * 128; col = s * 128;
        } else if (seg < 264) {
            const int s = seg - 176, p = s >> 1, hf = s & 1; W = hf ? P.w_up : P.w_gate; ldn = FF_; ksc = P.norm_ffn; WT = (bf16_t*)(P.ws + WS_WGU); row = s * 128; col = p * 128;
        } else {
            const int s = seg - 264; W = P.w_down; ldn = D_; WT = (bf16_t*)(P.ws + WS_WD); row = s * 128; col = s * 128;
        }
        tr_item(W, ldn, col + nb * 64, kb * 64, ksc, scal, WT, K, row + nb * 64, scr, lane);
    }
}

__device__ __forceinline__ void p0_rows(const Params& P, LAS unsigned char* lds, int tid, int lane, int gw, int NGW) {
    LAS f32x4* wif = (LAS f32x4*)lds;
    for (int p = tid; p < 8192; p += 512) { const int k = p >> 2, q = p & 3, l = (k & 255) >> 2, i = k & 3, j = k >> 8;
        const f32x4 v = *(const f32x4*)(P.w_in + (size_t)k * INW_ + 6144 + 4 * q) * P.norm_mix[k];
        wif[((j * 4 + i) * 4 + q) * 64 + l] = v; }
    __syncthreads();
    bf16_t* XB = (bf16_t*)P.out; float* GATES = (float*)(P.ws + WS_GATES);
    for (int rr = gw; rr < M_; rr += NGW) {
        const int row = row_of(rr);
        const f32x4* xr = (const f32x4*)(P.x + (size_t)row * D_) + lane;
        f32x4 v[8]; float ss = 0.f;
#pragma unroll
        for (int j = 0; j < 8; ++j) { v[j] = xr[64 * j]; ss += (v[j][0] * v[j][0] + v[j][1] * v[j][1]) + (v[j][2] * v[j][2] + v[j][3] * v[j][3]); }
        const float rs = 1.0f / sqrtf(wave_sum(ss) * (1.f / D_) + EPS_);
        u32x2* o8 = (u32x2*)(XB + (size_t)row * D_) + lane;
        f32x4 a[4] = {(f32x4){0.f, 0.f, 0.f, 0.f}, (f32x4){0.f, 0.f, 0.f, 0.f}, (f32x4){0.f, 0.f, 0.f, 0.f}, (f32x4){0.f, 0.f, 0.f, 0.f}};
#pragma unroll
        for (int j = 0; j < 8; ++j) { v[j] = v[j] * rs; u32x2 w; w.x = cvt_pk_bf16(v[j][0], v[j][1]); w.y = cvt_pk_bf16(v[j][2], v[j][3]); o8[64 * j] = w;
#pragma unroll
            for (int i = 0; i < 4; ++i)
#pragma unroll
                for (int q = 0; q < 4; ++q) a[q] += wif[((j * 4 + i) * 4 + q) * 64 + lane] * v[j][i]; }
#pragma unroll
        for (int q = 0; q < 4; ++q)
#pragma unroll
            for (int e = 0; e < 4; ++e) a[q][e] = wave_sum(a[q][e]);
        if (lane == 0) {
            f32x4 g0, g1, g2, g3;
#pragma unroll
            for (int e = 0; e < 4; ++e) { g0[e] = a[0][e] + P.b_i[e]; g1[e] = a[1][e] + P.b_i[4 + e];
                const float f0 = a[2][e] + P.b_f[e], f1 = a[3][e] + P.b_f[4 + e];
                g2[e] = fminf(f0, 0.f) - log1pf(expf(-fabsf(f0))); g3[e] = fminf(f1, 0.f) - log1pf(expf(-fabsf(f1))); }
            f32x4* go = (f32x4*)(GATES + (size_t)row * 16); go[0] = g0; go[1] = g1; go[2] = g2; go[3] = g3;
        }
    }
}

__device__ __forceinline__ void unpack8(const u32x4 w, float (&f)[8]) { f[0] = bf_lo(w.x); f[1] = bf_hi(w.x); f[2] = bf_lo(w.y); f[3] = bf_hi(w.y); f[4] = bf_lo(w.z); f[5] = bf_hi(w.z); f[6] = bf_lo(w.w); f[7] = bf_hi(w.w); }
__device__ __forceinline__ u32x4 pack8f(const float (&f)[8]) { u32x4 w; w.x = cvt_pk_bf16(f[0], f[1]); w.y = cvt_pk_bf16(f[2], f[3]); w.z = cvt_pk_bf16(f[4], f[5]); w.w = cvt_pk_bf16(f[6], f[7]); return w; }

__device__ __forceinline__ void p2a_conv(const Params& P, int tid, int vc) {
    bf16_t* CB = (bf16_t*)P.out + (size_t)M_ * D_; const bf16_t* CCX = (const bf16_t*)(P.ws + WS_CCX);
    const int cg8 = (tid & 255) * 8, rs = tid >> 8;
    float w0[8], w1[8], w2[8];
#pragma unroll
    for (int e = 0; e < 8; ++e) { w0[e] = P.conv_w[cg8 + e]; w1[e] = P.conv_w[D_ + cg8 + e]; w2[e] = P.conv_w[2 * D_ + cg8 + e]; }
    for (int it_ = vc; it_ < M_ / 64; it_ += gridDim.x) {
        const int it = item_of(it_);
        const int r0 = it * 64 + rs * 32;
        float p2[8], p1[8];
        if ((r0 & (SEQ_ - 1)) == 0) {
#pragma unroll
            for (int e = 0; e < 8; ++e) { p2[e] = 0.f; p1[e] = 0.f; }
        } else { unpack8(*(const u32x4*)(CCX + (size_t)(r0 - 2) * D_ + cg8), p2); unpack8(*(const u32x4*)(CCX + (size_t)(r0 - 1) * D_ + cg8), p1); }
#pragma unroll 4
        for (int i = 0; i < 32; ++i) { const size_t o = (size_t)(r0 + i) * D_ + cg8;
            float c[8], b[8], y[8]; unpack8(*(const u32x4*)(CCX + o), c); unpack8(*(const u32x4*)(CB + o), b);
#pragma unroll
            for (int e = 0; e < 8; ++e) { y[e] = b[e] * (w0[e] * p2[e] + w1[e] * p1[e] + w2[e] * c[e]); p2[e] = p1[e]; p1[e] = c[e]; }
            *(u32x4*)(CB + o) = pack8f(y); }
    }
}
__device__ __forceinline__ void p2c_hnorm(const Params& P, int tid, int vc) {
    bf16_t* H = (bf16_t*)P.out; const bf16_t* O = (const bf16_t*)(P.ws + WS_O); const float* SSQH = (const float*)(P.ws + WS_SSQH);
    const int cg8 = (tid & 255) * 8, rs = tid >> 8, hd = (tid & 255) >> 5;
    float g[8];
#pragma unroll
    for (int e = 0; e < 8; ++e) g[e] = P.mh_norm[cg8 + e];
    for (int it_ = vc; it_ < M_ / 64; it_ += gridDim.x) {
        const int it = item_of(it_);
        const int r0 = it * 64 + rs * 32;
#pragma unroll 4
        for (int i = 0; i < 32; ++i) { const int r = r0 + i; const size_t o = (size_t)r * D_ + cg8;
            const f32x4 q = *(const f32x4*)(SSQH + (size_t)r * 32 + hd * 4);
            const float rn = 1.0f / sqrtf(((q[0] + q[1]) + (q[2] + q[3])) * (1.f / 256.f) + EPS_);
            float h[8], s[8], y[8]; unpack8(*(const u32x4*)(H + o), h); unpack8(*(const u32x4*)(O + o), s);
#pragma unroll
            for (int e = 0; e < 8; ++e) y[e] = s[e] * (h[e] * rn * g[e]);
            *(u32x4*)(H + o) = pack8f(y); }
    }
}
__device__ __forceinline__ void p7_final(const Params& P, int lane, int gw, int NGW) {
    const float* SSQ = (const float*)(P.ws + WS_SSQ3);
    f32x4 g[8];
#pragma unroll
    for (int j = 0; j < 8; ++j) g[j] = ((const f32x4*)P.norm_final)[lane + 64 * j];
    for (int rr = gw; rr < M_; rr += NGW) {
        const int row = row_of(rr);
        f32x4* xr = (f32x4*)(P.out + (size_t)row * D_) + lane;
        const float part = lane < 32 ? SSQ[(size_t)row * 32 + lane] : 0.f;
        const float rs = 1.0f / sqrtf(wave_sum(part) * (1.f / D_) + EPS_);
#pragma unroll
        for (int j = 0; j < 8; ++j) { const f32x4 v = xr[64 * j]; xr[64 * j] = v * rs * g[j]; }
    }
}

__device__ __forceinline__ unsigned off_b(unsigned row, unsigned ch) { return 256u * row + 16u * (ch ^ (((row & 3) << 2) | ((row >> 2) & 3))); }
__device__ __forceinline__ bf16x8 row_frag(const LAS unsigned char* img, unsigned lane, unsigned rb, unsigned s) {
    return *(const LAS bf16x8*)(img + off_b((lane & 15) + 16 * rb, 4 * s + (lane >> 4)));
}
__device__ __forceinline__ bf16x8 tr_frag(LAS unsigned char* img, unsigned lane, unsigned c, unsigned ks) {
    const unsigned g = lane >> 4, q = (lane & 15) >> 2, p = lane & 3, row = 32 * ks + 8 * g + q, ch = 2 * c + (p >> 1);
    const s16x4 lo = __builtin_amdgcn_ds_read_tr16_b64_v4i16((LAS s16x4*)(img + off_b(row, ch) + 8 * (p & 1)));
    const s16x4 hi = __builtin_amdgcn_ds_read_tr16_b64_v4i16((LAS s16x4*)(img + off_b(row + 4, ch) + 8 * (p & 1)));
    return (bf16x8){lo[0], lo[1], lo[2], lo[3], hi[0], hi[1], hi[2], hi[3]};
}
constexpr int ML_Q = 0, ML_K = 32768, ML_V = 65536, ML_P = 98304, ML_CT = 131072, ML_SM = 151552;

__device__ __forceinline__ void p2b_mlstm(const Params& P, LAS unsigned char* lds, int tid, int w, int lane, int vc) {
    const bf16_t* QK = (const bf16_t*)(P.ws + WS_QK); const bf16_t* V = (const bf16_t*)(P.ws + WS_V); const float* GATES = (const float*)(P.ws + WS_GATES);
    bf16_t* H = (bf16_t*)P.out; float* SSQH = (float*)(P.ws + WS_SSQH);
    LAS unsigned char* Qi = lds + ML_Q; LAS unsigned char* Ki = lds + ML_K; LAS unsigned char* Vi = lds + ML_V; LAS unsigned char* Pi = lds + ML_P; LAS unsigned char* Ci = lds + ML_CT;
    LAS float* sm_a = (LAS float*)(lds + ML_SM); LAS float* sm_M = sm_a + 128; LAS float* sm_in = sm_a + 256; LAS float* sm_emc = sm_a + 384; LAS float* sm_wk = sm_a + 512; LAS float* sm_dec = sm_a + 640;
    const int tb = w < 4 ? w : 11 - w;
    const int g4 = lane >> 4, l15 = lane & 15;
    for (int uu = vc; uu < 256; uu += gridDim.x) {
        const int unit = (uu & 7) * 32 + (uu >> 3);
        const int b = unit >> 5, hd = (unit >> 2) & 7, sl = unit & 3;
        const size_t rowbase = (size_t)b * SEQ_;
        __syncthreads();
        if (tid < 256) { const int row = tid >> 1, ch = 8 + (tid & 1); u32x4 z = (u32x4){0u, 0u, 0u, 0u}; if (ch == 8) z.x = 0x3F80u; *(LAS u32x4*)(Vi + off_b(row, ch)) = z; }
        f32x4 C[5];
#pragma unroll
        for (int jb = 0; jb < 5; ++jb) C[jb] = (f32x4){0.f, 0.f, 0.f, 0.f};
        float mst = 0.f;
        u32x4 pq[4], pk[4], pv[2]; float gl[4] = {0.f, 0.f, 0.f, 0.f};
#define ML_LOAD(cc) do { const size_t t0_ = rowbase + (size_t)(cc) * 128; \
        _Pragma("unroll") for (int i = 0; i < 4; ++i) { const int p = tid + 512 * i, row = p >> 4, ch = p & 15; const bf16_t* src = QK + (t0_ + row) * D_ + hd * 128 + ch * 8; pq[i] = *(const u32x4*)src; pk[i] = *(const u32x4*)(src + 1024); } \
        _Pragma("unroll") for (int i = 0; i < 2; ++i) { const int p = tid + 512 * i, row = p >> 3, ch = p & 7; pv[i] = *(const u32x4*)(V + (t0_ + row) * D_ + hd * 256 + sl * 64 + ch * 8); } \
        if (w == 0) { const float* gp = GATES + (t0_ + 2 * lane) * 16 + hd; gl[0] = gp[0]; gl[1] = gp[8]; gl[2] = gp[16]; gl[3] = gp[24]; } } while (0)
        ML_LOAD(0);
        for (int c = 0; c < 16; ++c) {
            const size_t t0 = rowbase + (size_t)c * 128;
#pragma unroll
            for (int i = 0; i < 4; ++i) { const int p = tid + 512 * i, row = p >> 4, ch = p & 15; *(LAS u32x4*)(Qi + off_b(row, ch)) = pq[i]; *(LAS u32x4*)(Ki + off_b(row, ch)) = pk[i]; }
#pragma unroll
            for (int i = 0; i < 2; ++i) { const int p = tid + 512 * i, row = p >> 3, ch = p & 7; *(LAS u32x4*)(Vi + off_b(row, ch)) = pv[i]; }
#pragma unroll
            for (int jb = 0; jb < 5; ++jb) { u32x2 wv; wv.x = cvt_pk_bf16(C[jb][0], C[jb][1]); wv.y = cvt_pk_bf16(C[jb][2], C[jb][3]);
                *(LAS u32x2*)(Ci + off_b(16 * jb + l15, 2 * w + (lane >> 5)) + 8 * (g4 & 1)) = wv; }
            if (w == 0) {
                const float li0 = gl[0], lf0 = gl[1], li1 = gl[2], lf1 = gl[3];
                const float ps = lf0 + lf1; float incl = ps;
#pragma unroll
                for (int o = 1; o < 64; o <<= 1) { const float t = __shfl_up(incl, o); if (lane >= o) incl += t; }
                const float b0 = (incl - ps) + lf0, b1 = incl;
                const float a0 = li0 - b0, a1 = li1 - b1;
                float cm = fmaxf(a0, a1);
#pragma unroll
                for (int o = 1; o < 64; o <<= 1) { const float t = __shfl_up(cm, o); if (lane >= o) cm = fmaxf(cm, t); }
                float cme = __shfl_up(cm, 1); if (lane == 0) cme = -INFINITY;
                const float M0 = fmaxf(mst, fmaxf(cme, a0)), M1 = fmaxf(mst, cm);
                const float gtot = __shfl(incl, 63), Ml = __shfl(M1, 63);
                sm_a[2 * lane] = a0; sm_a[2 * lane + 1] = a1; sm_M[2 * lane] = M0; sm_M[2 * lane + 1] = M1;
                sm_in[2 * lane] = __expf(mst - M0); sm_in[2 * lane + 1] = __expf(mst - M1);
                sm_emc[2 * lane] = __expf(-(b0 + M0)); sm_emc[2 * lane + 1] = __expf(-(b1 + M1));
                sm_wk[2 * lane] = __expf(a0 - Ml); sm_wk[2 * lane + 1] = __expf(a1 - Ml);
                if (lane == 0) sm_dec[0] = __expf(mst - Ml);
                mst = gtot + Ml;
            }
            __syncthreads();
            if (c + 1 < 16) ML_LOAD(c + 1);
            bf16x8 qf[4];
#pragma unroll
            for (int s = 0; s < 4; ++s) qf[s] = row_frag(Qi, lane, tb, s);
            const float Mt = sm_M[16 * tb + l15];
            const int tloc = 16 * tb + l15;
            for (int sb = 0; sb <= tb; ++sb) {
                f32x4 sa = (f32x4){0.f, 0.f, 0.f, 0.f};
#pragma unroll
                for (int s = 0; s < 4; ++s) sa = __builtin_amdgcn_mfma_f32_16x16x32_bf16(row_frag(Ki, lane, sb, s), qf[s], sa, 0, 0, 0);
                const f32x4 a4 = *(const LAS f32x4*)(sm_a + 16 * sb + 4 * g4);
                float pe[4];
#pragma unroll
                for (int i = 0; i < 4; ++i) { const int sidx = 16 * sb + 4 * g4 + i; pe[i] = sidx <= tloc ? sa[i] * __expf(a4[i] - Mt) : 0.f; }
                u32x2 wv; wv.x = cvt_pk_bf16(pe[0], pe[1]); wv.y = cvt_pk_bf16(pe[2], pe[3]);
                *(LAS u32x2*)(Pi + off_b(tloc, 2 * sb + (lane >> 5)) + 8 * (g4 & 1)) = wv;
            }
            if ((tb & 1) == 0) *(LAS u32x2*)(Pi + off_b(tloc, 2 * (tb + 1) + (lane >> 5)) + 8 * (g4 & 1)) = (u32x2){0u, 0u};
            const int nks = (tb + 2) >> 1;
            f32x4 o1[5], o2[5];
#pragma unroll
            for (int jb = 0; jb < 5; ++jb) { o1[jb] = (f32x4){0.f, 0.f, 0.f, 0.f}; o2[jb] = (f32x4){0.f, 0.f, 0.f, 0.f}; }
            const float dec = sm_dec[0];
#pragma unroll
            for (int jb = 0; jb < 5; ++jb) C[jb] = C[jb] * dec;
#pragma unroll
            for (int s = 0; s < 4; ++s)
#pragma unroll
                for (int jb = 0; jb < 5; ++jb) o2[jb] = __builtin_amdgcn_mfma_f32_16x16x32_bf16(qf[s], row_frag(Ci, lane, jb, s), o2[jb], 0, 0, 0);
            for (int ks = 0; ks < 4; ++ks) {
                bf16x8 vf[5];
#pragma unroll
                for (int jb = 0; jb < 5; ++jb) vf[jb] = tr_frag(Vi, lane, jb, ks);
                if (ks < nks) { const bf16x8 pf = row_frag(Pi, lane, tb, ks);
#pragma unroll
                    for (int jb = 0; jb < 5; ++jb) o1[jb] = __builtin_amdgcn_mfma_f32_16x16x32_bf16(pf, vf[jb], o1[jb], 0, 0, 0); }
                const bf16x8 kt = tr_frag(Ki, lane, w, ks);
                const f32x4 w0 = *(const LAS f32x4*)(sm_wk + 32 * ks + 8 * g4), w1 = *(const LAS f32x4*)(sm_wk + 32 * ks + 8 * g4 + 4);
                bf16x8 kf; unsigned kw[4];
#pragma unroll
                for (int e = 0; e < 4; ++e) { const float lo = __uint_as_float(((unsigned)(unsigned short)kt[2 * e]) << 16) * (e < 2 ? w0[2 * e] : w1[2 * e - 4]);
                    const float hi = __uint_as_float(((unsigned)(unsigned short)kt[2 * e + 1]) << 16) * (e < 2 ? w0[2 * e + 1] : w1[2 * e - 3]); kw[e] = cvt_pk_bf16(lo, hi); }
                kf = __builtin_bit_cast(bf16x8, (u32x4){kw[0], kw[1], kw[2], kw[3]});
#pragma unroll
                for (int jb = 0; jb < 5; ++jb) C[jb] = __builtin_amdgcn_mfma_f32_16x16x32_bf16(kf, vf[jb], C[jb], 0, 0, 0);
            }
            const f32x4 in4 = *(const LAS f32x4*)(sm_in + 16 * tb + 4 * g4), em4 = *(const LAS f32x4*)(sm_emc + 16 * tb + 4 * g4);
            float sc[4], ssq[4];
#pragma unroll
            for (int i = 0; i < 4; ++i) { const float den = __shfl(o1[4][i] + in4[i] * o2[4][i], lane & 48); sc[i] = __builtin_amdgcn_rcpf(fmaxf(fabsf(den), em4[i])); ssq[i] = 0.f; }
            LAS unsigned char* tmp = Pi + 4096 * tb;
#pragma unroll
            for (int jb = 0; jb < 4; ++jb)
#pragma unroll
                for (int i = 0; i < 4; ++i) { const float hv = (o1[jb][i] + in4[i] * o2[jb][i]) * sc[i]; ssq[i] += hv * hv;
                    *(LAS unsigned short*)(tmp + (4 * g4 + i) * 128 + (16 * jb + l15) * 2) = (unsigned short)(cvt_pk_bf16(hv, 0.f) & 0xffffu); }
#pragma unroll
            for (int i = 0; i < 4; ++i) { float s = ssq[i]; s += __shfl_xor(s, 1); s += __shfl_xor(s, 2); s += __shfl_xor(s, 4); s += __shfl_xor(s, 8);
                if (l15 == 0) SSQH[(t0 + 16 * tb + 4 * g4 + i) * 32 + hd * 4 + sl] = s; }
#pragma unroll
            for (int i = 0; i < 2; ++i) { const int row = lane >> 2, ch = (lane & 3) * 2 + i;
                *(u32x4*)(H + (t0 + 16 * tb + row) * D_ + hd * 256 + sl * 64 + ch * 8) = *(const LAS u32x4*)(tmp + row * 128 + ch * 16); }
            __syncthreads();
        }
#undef ML_LOAD
    }
}

__global__ void __launch_bounds__(512, 2) mk_fwd(Params P) {
    extern __shared__ __attribute__((aligned(16))) unsigned char lds_raw[];
    LAS unsigned char* lds = (LAS unsigned char*)lds_raw;
    const int tid = threadIdx.x, lane = tid & 63, wave = __builtin_amdgcn_readfirstlane(tid >> 6);
    const int G = gridDim.x;
    unsigned char* ws = P.ws;
    int vc;
    {
        unsigned* ctr = (unsigned*)(ws + WS_CTR); LAS unsigned* sh = (LAS unsigned*)(lds + LDS_BYTES - 16);
        if (tid == 0) { const unsigned x = (unsigned)__builtin_amdgcn_s_getreg((3 << 11) | 20) & 7u;
            const unsigned r = __hip_atomic_fetch_add(ctr + x * 64, 1u, __ATOMIC_RELAXED, __HIP_MEMORY_SCOPE_AGENT); sh[0] = x | (r << 8); }
        __syncthreads();
        const unsigned v = sh[0];
        asm volatile("s_waitcnt vmcnt(0)" ::: "memory"); __syncthreads(); cg::this_grid().sync();
        bool even = (G % 8) == 0;
        for (int x = 0; x < 8; ++x) even = even && (__hip_atomic_load(ctr + x * 64, __ATOMIC_RELAXED, __HIP_MEMORY_SCOPE_AGENT) == (unsigned)(G / 8));
        vc = even ? (int)((v & 7u) + 8u * (v >> 8)) : (int)blockIdx.x;
        vc = __builtin_amdgcn_readfirstlane(vc);
    }
    const int gw = vc * 8 + wave, NGW = G * 8;
#define IN(k) (P.ph_lo <= (k) && (k) < P.ph_hi)
#define GRID_SYNC() do { asm volatile("s_waitcnt vmcnt(0)" ::: "memory"); __syncthreads(); cg::this_grid().sync(); \
        if (tid == 0) { __builtin_amdgcn_fence(__ATOMIC_ACQUIRE, "agent"); asm volatile("s_waitcnt vmcnt(0)" ::: "memory"); } __syncthreads(); } while (0)
#if MK_TSEL >= 0
    LAS unsigned long long* stamps = (LAS unsigned long long*)(lds + LDS_BYTES - 512);
#define STAMP(k) do { if (blockIdx.x == 0 && tid == 0) stamps[k] = __builtin_amdgcn_s_memrealtime(); } while (0)
#else
#define STAMP(k) do { } while (0)
#endif
#define SEAM(k) do { if (IN(k) && IN((k) + 1)) GRID_SYNC(); STAMP((k) + 1); } while (0)
    STAMP(0);
    bf16_t* XB = (bf16_t*)P.out; bf16_t* CU = XB + (size_t)M_ * D_;
    if (IN(0)) { p0_weights(P, lds, wave, lane, gw, NGW); __syncthreads(); p0_rows(P, lds, tid, lane, gw, NGW); __syncthreads(); }
    SEAM(0);
    if (IN(1)) { pg8::Gemm g{XB, XB, (const bf16_t*)(ws + WS_WA1), 1 << 30, D_}; pg8::StaticOrder S; S.init(M_, 6144, G, vc);
        pg8::EpiP1a E{CU, (bf16_t*)(ws + WS_CCX)}; pg8::gemm_phase(lds, g, S, E); }
    SEAM(1);
    if (IN(2)) p2a_conv(P, tid, vc);
    SEAM(2);
    if (IN(3)) { pg8::Gemm g{XB, XB, (const bf16_t*)(ws + WS_WB1), 1 << 30, D_}; pg8::StaticOrder S; S.init(M_, 10240, G, vc);
        pg8::EpiP1b E{(bf16_t*)(ws + WS_QK)}; pg8::gemm_phase(lds, g, S, E); }
    SEAM(3);
    if (IN(4)) p2b_mlstm(P, lds, tid, wave, lane, vc);
    SEAM(4);
    if (IN(5)) p2c_hnorm(P, tid, vc);
    SEAM(5);
    if (IN(6)) { pg8::Gemm g{XB, CU, (const bf16_t*)(ws + WS_WAB), 8, D_}; pg8::PairOrder S; S.init(M_, D_, G, vc);
        pg8::EpiP3 E{(const bf16_t*)(ws + WS_GA), (const bf16_t*)(ws + WS_GB), (bf16_t*)(ws + WS_MG)}; pg8::gemm_phase(lds, g, S, E); }
    SEAM(6);
    if (IN(7)) { pg8::Gemm g{(const bf16_t*)(ws + WS_MG), nullptr, (const bf16_t*)(ws + WS_WO), 1 << 30, D_}; pg8::StaticOrder S; S.init(M_, D_, G, vc);
        pg8::EpiP4 E{P.x, P.out, (bf16_t*)(ws + WS_X1B), (float*)(ws + WS_SSQ2)}; pg8::gemm_phase(lds, g, S, E); }
    SEAM(7);
    if (IN(8)) { pg8::Gemm g{(const bf16_t*)(ws + WS_X1B), nullptr, (const bf16_t*)(ws + WS_WGU), 1 << 30, D_}; pg8::StaticOrder S; S.init(M_, 2 * FF_, G, vc);
        pg8::EpiP5 E{(const float*)(ws + WS_SSQ2), (bf16_t*)(ws + WS_ACT)}; pg8::gemm_phase(lds, g, S, E); }
    SEAM(8);
    if (IN(9)) { pg8::Gemm g{(const bf16_t*)(ws + WS_ACT), nullptr, (const bf16_t*)(ws + WS_WD), 1 << 30, FF_}; pg8::StaticOrder S; S.init(M_, D_, G, vc);
        pg8::EpiP6 E{P.out, (float*)(ws + WS_SSQ3)}; pg8::gemm_phase(lds, g, S, E); }
    SEAM(9);
    if (IN(10)) p7_final(P, lane, gw, NGW);
#if MK_TSEL >= 0
    GRID_SYNC(); STAMP(11);
    if (blockIdx.x == 0) { __syncthreads(); const unsigned long long dt = stamps[MK_TEND] - stamps[MK_TSEL]; int n = (int)(dt / 100ull); if (n > 30000) n = 30000;
        for (int i = tid; i < n; i += 512) P.out[i] += 0.1f; }
#endif
#undef IN
#undef SEAM
}

extern "C" void kernel_launch(void* const* d_in, const int* in_sizes, int n_in, void* d_out, int out_size, void* d_ws, size_t ws_size, hipStream_t stream) {
    static int grid = 0;
    if (grid == 0) {
        if (n_in != 15 || out_size != M_ * D_ || ws_size < WS_END) { fprintf(stderr, "kernel_launch: unexpected shapes (n_in %d out %d ws %zu, need %zu)\n", n_in, out_size, ws_size, (size_t)WS_END); grid = -1; return; }
        int dev = 0, cus = 0, per_cu = 0;
        (void)hipGetDevice(&dev); (void)hipDeviceGetAttribute(&cus, hipDeviceAttributeMultiprocessorCount, dev);
        if (hipFuncSetAttribute((const void*)mk_fwd, hipFuncAttributeMaxDynamicSharedMemorySize, LDS_BYTES) != hipSuccess) { fprintf(stderr, "kernel_launch: hipFuncSetAttribute failed\n"); grid = -1; return; }
        if (hipOccupancyMaxActiveBlocksPerMultiprocessor(&per_cu, (const void*)mk_fwd, 512, LDS_BYTES) != hipSuccess || per_cu < 1) { per_cu = 1; (void)hipGetLastError(); }
        if (cus <= 0) cus = 256;
        grid = cus * per_cu;
        fprintf(stderr, "kernel_launch: grid %d (cus %d x %d)\n", grid, cus, per_cu);
    }
    if (grid < 0) return;
    Params p{};
    p.x = (const float*)d_in[0]; p.norm_mix = (const float*)d_in[1]; p.w_in = (const float*)d_in[2]; p.b_i = (const float*)d_in[3]; p.b_f = (const float*)d_in[4];
    p.conv_w = (const float*)d_in[5]; p.mh_norm = (const float*)d_in[6]; p.w_a = (const float*)d_in[7]; p.w_b = (const float*)d_in[8]; p.w_out = (const float*)d_in[9];
    p.norm_ffn = (const float*)d_in[10]; p.w_gate = (const float*)d_in[11]; p.w_up = (const float*)d_in[12]; p.w_down = (const float*)d_in[13]; p.norm_final = (const float*)d_in[14];
    p.out = (float*)d_out; p.ws = (unsigned char*)d_ws;
    p.ph_lo = 0; p.ph_hi = MK_STOP;
    (void)hipMemsetAsync((unsigned char*)d_ws + WS_CTR, 0, 4096, stream);
    void* args[] = {&p};
    hipError_t e = hipLaunchCooperativeKernel((const void*)mk_fwd, dim3(grid), dim3(512), args, LDS_BYTES, stream);
    if (e != hipSuccess) fprintf(stderr, "kernel_launch: cooperative launch failed: %s (grid %d)\n", hipGetErrorString(e), grid);
}
```
